# Optimizing an MI355X kernel written in HIP

```python
import math
import jax, jax.numpy as jnp
from jax import lax
import numpy as np

D_MODEL = 2048
BATCH = 8
SEQ = 4096
DEPTH = 2
DEC_BATCH = 8
DEC_SEQ = 64
PAST_LEN = 4096

CHUNK = 64
Q_BLOCK = 128
HEAD_DIM = 128
H_A = D_MODEL // (2 * HEAD_DIM)
H_B = D_MODEL // (2 * HEAD_DIM)
H_C = D_MODEL // HEAD_DIM
DA_HALF = HEAD_DIM // 2
WA = H_A * HEAD_DIM
WB = H_B * HEAD_DIM
AB_IN = 3 * WA + 3 * WB + H_B
AB_OUT = WA + WB
C_W = H_C * HEAD_DIM
N_T5_BUCKETS = 32
T5_MAX_DIST = 128
C_PREV_CHUNKS = 8
C_BAND = C_PREV_CHUNKS * CHUNK
REL_CLIP = 128
D_FF = ((8 * D_MODEL // 3 + 127) // 128) * 128
N_AB_LAYERS = (DEPTH + 1) // 2
N_C_LAYERS = DEPTH // 2
FORGET_BIAS_INIT = 2.0
EPS = 1e-6
NEG_INF = -1e30

kernel_name = 'hybrid_streaming_encoder_step'


def rmsnorm(x, g):
    xf = x.astype(jnp.float32)
    y = xf * lax.rsqrt(jnp.mean(xf * xf, axis=-1, keepdims=True) + EPS)
    return (y * g.astype(jnp.float32)).astype(x.dtype)


def modulate(x, g, shift, scale):
    return rmsnorm(x, g) * (1.0 + scale[:, None, :]) + shift[:, None, :]


def ada_mods(c, w, b):
    m = jax.nn.silu(c) @ w + b
    s = jnp.split(m, 9, axis=-1)
    return s[0:3], s[3:6], s[6:9]


def swiglu(h, w_in, w_out):
    g, u = jnp.split(h @ w_in, 2, axis=-1)
    return (jax.nn.silu(g) * u) @ w_out


def ffn_residual(x, mod, g, w_in, w_out):
    shift, scale, gate = mod
    return x + 0.5 * gate[:, None, :] * swiglu(modulate(x, g, shift, scale), w_in, w_out)


def to_blocks(a, size):
    b, t = a.shape[0], a.shape[1]
    return jnp.moveaxis(a.reshape((b, t // size, size) + a.shape[2:]), 1, 0)


def from_blocks(a):
    a = jnp.moveaxis(a, 0, 1)
    return a.reshape((a.shape[0], a.shape[1] * a.shape[2]) + a.shape[3:])


def chunk_id(pos):
    return jnp.floor_divide(pos, CHUNK)


def t5_bucket(rel):
    nb = N_T5_BUCKETS // 2
    max_exact = nb // 2
    n = jnp.abs(rel)
    nf = jnp.maximum(n, 1).astype(jnp.float32)
    large = max_exact + (jnp.log(nf / max_exact) / math.log(T5_MAX_DIST / max_exact) * (nb - max_exact)).astype(jnp.int32)
    large = jnp.minimum(large, nb - 1)
    return jnp.where(rel > 0, nb, 0) + jnp.where(n < max_exact, n, large)


def diff_attn(q, k, v, q_pos, k_pos, t5_table, lam, lam_init, subln_g):
    b, tq = q.shape[0], q.shape[1]
    tk = k.shape[1]
    q2 = q.reshape(b, tq, H_A, 2, DA_HALF)
    k2 = k.reshape(b, tk, H_A, 2, DA_HALF)
    s = jnp.einsum('bqhmd,bkhmd->bmhqk', q2, k2).astype(jnp.float32) * (DA_HALF ** -0.5)
    bias = jnp.transpose(t5_table[t5_bucket(k_pos[None, :] - q_pos[:, None])], (2, 0, 1)).astype(jnp.float32)
    mask = chunk_id(k_pos)[None, :] <= chunk_id(q_pos)[:, None]
    p = jax.nn.softmax(jnp.where(mask, s + bias, NEG_INF), axis=-1)
    attn = p[:, 0] - lam * p[:, 1]
    o = jnp.einsum('bhqk,bkhd->bqhd', attn.astype(v.dtype), v)
    o = rmsnorm(o, subln_g) * (1.0 - lam_init)
    return o.reshape(b, tq, WA)


def fox_attn(q, k, v, f_q, f_k, q_pos, k_pos):
    b, tq = q.shape[0], q.shape[1]
    s = jnp.einsum('bqhd,bkhd->bhqk', q, k).astype(jnp.float32) * (HEAD_DIM ** -0.5)
    decay = jnp.transpose(f_q, (0, 2, 1))[:, :, :, None] - jnp.transpose(f_k, (0, 2, 1))[:, :, None, :]
    mask = k_pos[None, :] <= q_pos[:, None]
    p = jax.nn.softmax(jnp.where(mask, s + decay, NEG_INF), axis=-1)
    o = jnp.einsum('bhqk,bkhd->bqhd', p.astype(v.dtype), v)
    return o.reshape(b, tq, WB)


def band_attn(q, k, v, q_pos, k_pos, rel_table):
    b, tq = q.shape[0], q.shape[1]
    s = jnp.einsum('bqhd,bkhd->bhqk', q, k).astype(jnp.float32) * (HEAD_DIM ** -0.5)
    rel = jnp.clip(k_pos[None, :] - q_pos[:, None], -REL_CLIP, REL_CLIP) + REL_CLIP
    bias = jnp.transpose(rel_table[rel], (2, 0, 1)).astype(jnp.float32)
    qc = chunk_id(q_pos)[:, None]
    kc = chunk_id(k_pos)[None, :]
    mask = (kc <= qc) & (qc - kc <= C_PREV_CHUNKS) & (k_pos[None, :] >= 0)
    p = jax.nn.softmax(jnp.where(mask, s + bias, NEG_INF), axis=-1)
    o = jnp.einsum('bhqk,bkhd->bqhd', p.astype(v.dtype), v)
    return o.reshape(b, tq, C_W)


def ab_project(h, w_in, b_f):
    b, t, _ = h.shape
    cuts = [WA, 2 * WA, 3 * WA, 3 * WA + WB, 3 * WA + 2 * WB, 3 * WA + 3 * WB]
    qa, ka, va, qb, kb, vb, f = jnp.split(h @ w_in, cuts, axis=-1)
    sa = (b, t, H_A, HEAD_DIM)
    sb = (b, t, H_B, HEAD_DIM)
    logf = jax.nn.log_sigmoid(f.astype(jnp.float32) + b_f.astype(jnp.float32))
    return qa.reshape(sa), ka.reshape(sa), va.reshape(sa), qb.reshape(sb), kb.reshape(sb), vb.reshape(sb), logf


def ab_mix_prompt(h, w_in, b_f, w_out, lam, lam_init, subln_g, t5_table):
    b, s, _ = h.shape
    qa, ka, va, qb, kb, vb, logf = ab_project(h, w_in, b_f)
    f_cum = jnp.cumsum(logf, axis=1)
    pos = jnp.arange(s)

    def block(args):
        qa_blk, qb_blk, f_blk, pos_blk = args
        oa = diff_attn(qa_blk, ka, va, pos_blk, pos, t5_table, lam, lam_init, subln_g)
        ob = fox_attn(qb_blk, kb, vb, f_blk, f_cum, pos_blk, pos)
        return jnp.concatenate([oa, ob], axis=-1)

    o = lax.map(block, (to_blocks(qa, Q_BLOCK), to_blocks(qb, Q_BLOCK), to_blocks(f_cum, Q_BLOCK), pos.reshape(-1, Q_BLOCK)))
    return from_blocks(o) @ w_out, (ka, va, kb, vb, logf)


def ab_mix_sample(h, ck_a, cv_a, ck_b, cv_b, clogf, w_in, b_f, w_out, lam, lam_init, subln_g, t5_table):
    t = h.shape[1]
    p = clogf.shape[1]
    qa, ka, va, qb, kb, vb, logf = ab_project(h, w_in, b_f)
    ka_all = jnp.concatenate([ck_a, ka], axis=1)
    va_all = jnp.concatenate([cv_a, va], axis=1)
    kb_all = jnp.concatenate([ck_b, kb], axis=1)
    vb_all = jnp.concatenate([cv_b, vb], axis=1)
    f_cum = jnp.cumsum(jnp.concatenate([clogf.astype(jnp.float32), logf], axis=1), axis=1)
    k_pos = jnp.arange(p + t)
    q_pos = p + jnp.arange(t)
    oa = diff_attn(qa, ka_all, va_all, q_pos, k_pos, t5_table, lam, lam_init, subln_g)
    ob = fox_attn(qb, kb_all, vb_all, f_cum[:, p:], f_cum, q_pos, k_pos)
    return jnp.concatenate([oa, ob], axis=-1) @ w_out, (ka, va, kb, vb, logf)


def c_project(h, w_in):
    b, t, _ = h.shape
    q, k, v = jnp.split(h @ w_in, 3, axis=-1)
    shp = (b, t, H_C, HEAD_DIM)
    return q.reshape(shp), k.reshape(shp), v.reshape(shp)


def c_mix_prompt(h, w_in, w_out, rel_table):
    b, s, _ = h.shape
    q, k, v = c_project(h, w_in)
    pad = jnp.zeros((b, C_BAND, H_C, HEAD_DIM), k.dtype)
    kp = jnp.concatenate([pad, k], axis=1)
    vp = jnp.concatenate([pad, v], axis=1)
    band = jnp.arange(C_BAND + CHUNK)

    def chunk_step(args):
        q_c, c = args
        start = c * CHUNK
        k_c = lax.dynamic_slice_in_dim(kp, start, C_BAND + CHUNK, axis=1)
        v_c = lax.dynamic_slice_in_dim(vp, start, C_BAND + CHUNK, axis=1)
        return band_attn(q_c, k_c, v_c, start + jnp.arange(CHUNK), start - C_BAND + band, rel_table)

    o = lax.map(chunk_step, (to_blocks(q, CHUNK), jnp.arange(s // CHUNK)))
    keep = min(C_BAND, s)
    return from_blocks(o) @ w_out, (k[:, s - keep:], v[:, s - keep:])


def c_mix_sample(h, ck, cv, past_len, w_in, w_out, rel_table):
    t = h.shape[1]
    lc = ck.shape[1]
    q, k, v = c_project(h, w_in)
    k_all = jnp.concatenate([ck, k], axis=1)
    v_all = jnp.concatenate([cv, v], axis=1)
    k_pos = past_len - lc + jnp.arange(lc + t)
    q_pos = past_len + jnp.arange(t)
    o = band_attn(q, k_all, v_all, q_pos, k_pos, rel_table)
    return o @ w_out, (k, v)


def setup_inputs(seed: int = 0) -> dict:
    key = jax.random.key(seed)
    ks = jax.random.split(key, 32)

    def nrm(k, shape, s=1.0):
        return s * jax.random.normal(k, shape, jnp.float32)

    inv = D_MODEL ** -0.5
    lc = min(C_BAND, PAST_LEN)
    return {
        'x_prompt': nrm(ks[0], (BATCH, SEQ, D_MODEL)),
        'x_sample': nrm(ks[1], (DEC_BATCH, DEC_SEQ, D_MODEL)),
        'cache_a_k': nrm(ks[2], (N_AB_LAYERS, DEC_BATCH, PAST_LEN, H_A, HEAD_DIM)),
        'cache_a_v': nrm(ks[3], (N_AB_LAYERS, DEC_BATCH, PAST_LEN, H_A, HEAD_DIM)),
        'cache_b_k': nrm(ks[4], (N_AB_LAYERS, DEC_BATCH, PAST_LEN, H_B, HEAD_DIM)),
        'cache_b_v': nrm(ks[5], (N_AB_LAYERS, DEC_BATCH, PAST_LEN, H_B, HEAD_DIM)),
        'cache_b_logf': jax.nn.log_sigmoid(FORGET_BIAS_INIT + nrm(ks[6], (N_AB_LAYERS, DEC_BATCH, PAST_LEN, H_B))),
        'cache_c_k': nrm(ks[7], (N_C_LAYERS, DEC_BATCH, lc, H_C, HEAD_DIM)),
        'cache_c_v': nrm(ks[8], (N_C_LAYERS, DEC_BATCH, lc, H_C, HEAD_DIM)),
        'c_prompt': nrm(ks[9], (BATCH, D_MODEL)),
        'c_sample': nrm(ks[10], (DEC_BATCH, D_MODEL)),
        'w_ada': nrm(ks[11], (DEPTH, D_MODEL, 9 * D_MODEL), 0.5 * inv),
        'b_ada': nrm(ks[12], (DEPTH, 9 * D_MODEL), 0.02),
        'norm_g': 1.0 + nrm(ks[13], (DEPTH, 3, D_MODEL), 0.01),
        'w_ffn_in': nrm(ks[14], (DEPTH, 2, D_MODEL, 2 * D_FF), inv),
        'w_ffn_out': nrm(ks[15], (DEPTH, 2, D_FF, D_MODEL), D_FF ** -0.5),
        'w_in_ab': nrm(ks[16], (N_AB_LAYERS, D_MODEL, AB_IN), inv),
        'b_forget': FORGET_BIAS_INIT + nrm(ks[17], (N_AB_LAYERS, H_B), 0.1),
        'w_out_ab': nrm(ks[18], (N_AB_LAYERS, AB_OUT, D_MODEL), AB_OUT ** -0.5),
        'lambda_q1': nrm(ks[19], (N_AB_LAYERS, DA_HALF), 0.1),
        'lambda_k1': nrm(ks[20], (N_AB_LAYERS, DA_HALF), 0.1),
        'lambda_q2': nrm(ks[21], (N_AB_LAYERS, DA_HALF), 0.1),
        'lambda_k2': nrm(ks[22], (N_AB_LAYERS, DA_HALF), 0.1),
        'subln_g': 1.0 + nrm(ks[23], (N_AB_LAYERS, HEAD_DIM), 0.01),
        't5_table': nrm(ks[24], (N_T5_BUCKETS, H_A), 0.5),
        'w_in_c': nrm(ks[25], (N_C_LAYERS, D_MODEL, 3 * C_W), inv),
        'w_out_c': nrm(ks[26], (N_C_LAYERS, C_W, D_MODEL), C_W ** -0.5),
        'c_rel_bias': nrm(ks[27], (N_C_LAYERS, 2 * REL_CLIP + 1, H_C), 0.5),
        'final_g': 1.0 + nrm(ks[28], (D_MODEL,), 0.01),
    }


def reference(x_prompt, x_sample, cache_a_k, cache_a_v, cache_b_k, cache_b_v, cache_b_logf, cache_c_k, cache_c_v, c_prompt, c_sample, w_ada, b_ada, norm_g, w_ffn_in, w_ffn_out, w_in_ab, b_forget, w_out_ab, lambda_q1, lambda_k1, lambda_q2, lambda_k2, subln_g, t5_table, w_in_c, w_out_c, c_rel_bias, final_g):
    past_len = cache_b_logf.shape[2]
    xp, xs = x_prompt, x_sample
    ab_p, ab_s, c_p, c_s = [], [], [], []
    for l in range(DEPTH):
        i = l // 2
        mp = ada_mods(c_prompt, w_ada[l], b_ada[l])
        ms = ada_mods(c_sample, w_ada[l], b_ada[l])
        xp = ffn_residual(xp, mp[0], norm_g[l, 0], w_ffn_in[l, 0], w_ffn_out[l, 0])
        xs = ffn_residual(xs, ms[0], norm_g[l, 0], w_ffn_in[l, 0], w_ffn_out[l, 0])
        hp = modulate(xp, norm_g[l, 1], mp[1][0], mp[1][1])
        hs = modulate(xs, norm_g[l, 1], ms[1][0], ms[1][1])
        if l % 2 == 0:
            lam_init = 0.8 - 0.6 * math.exp(-0.3 * l)
            lam = (jnp.exp(jnp.sum(lambda_q1[i].astype(jnp.float32) * lambda_k1[i].astype(jnp.float32)))
                   - jnp.exp(jnp.sum(lambda_q2[i].astype(jnp.float32) * lambda_k2[i].astype(jnp.float32))) + lam_init)
            yp, st_p = ab_mix_prompt(hp, w_in_ab[i], b_forget[i], w_out_ab[i], lam, lam_init, subln_g[i], t5_table)
            ys, st_s = ab_mix_sample(hs, cache_a_k[i], cache_a_v[i], cache_b_k[i], cache_b_v[i], cache_b_logf[i],
                                     w_in_ab[i], b_forget[i], w_out_ab[i], lam, lam_init, subln_g[i], t5_table)
            ab_p.append(st_p)
            ab_s.append(st_s)
        else:
            yp, st_p = c_mix_prompt(hp, w_in_c[i], w_out_c[i], c_rel_bias[i])
            ys, st_s = c_mix_sample(hs, cache_c_k[i], cache_c_v[i], past_len, w_in_c[i], w_out_c[i], c_rel_bias[i])
            c_p.append(st_p)
            c_s.append(st_s)
        xp = xp + mp[1][2][:, None, :] * yp
        xs = xs + ms[1][2][:, None, :] * ys
        xp = ffn_residual(xp, mp[2], norm_g[l, 2], w_ffn_in[l, 1], w_ffn_out[l, 1])
        xs = ffn_residual(xs, ms[2], norm_g[l, 2], w_ffn_in[l, 1], w_ffn_out[l, 1])
    y_prompt = rmsnorm(xp, final_g)
    y_sample = rmsnorm(xs, final_g)
    a_k_p = jnp.stack([st[0] for st in ab_p])
    a_v_p = jnp.stack([st[1] for st in ab_p])
    b_k_p = jnp.stack([st[2] for st in ab_p])
    b_v_p = jnp.stack([st[3] for st in ab_p])
    b_f_p = jnp.stack([st[4] for st in ab_p])
    c_k_p = jnp.stack([st[0] for st in c_p])
    c_v_p = jnp.stack([st[1] for st in c_p])
    a_k_s = jnp.stack([st[0] for st in ab_s])
    a_v_s = jnp.stack([st[1] for st in ab_s])
    b_k_s = jnp.stack([st[2] for st in ab_s])
    b_v_s = jnp.stack([st[3] for st in ab_s])
    b_f_s = jnp.stack([st[4] for st in ab_s])
    c_k_s = jnp.stack([st[0] for st in c_s])
    c_v_s = jnp.stack([st[1] for st in c_s])
    return (y_prompt, y_sample, a_k_p, a_v_p, b_k_p, b_v_p, b_f_p, c_k_p, c_v_p, a_k_s, a_v_s, b_k_s, b_v_s, b_f_s, c_k_s, c_v_s)
```

```cpp
#include <hip/hip_runtime.h>
#include <cstdio>
#include <cstdint>

#ifndef MK_N_LAUNCHES
#define MK_N_LAUNCHES 1
#endif

#ifndef DIS
#define DIS 0
#endif
#define EN(bit) (!(((DIS) >> (bit)) & 1))
#define LAS __attribute__((address_space(3)))
typedef unsigned short bf16_t;
typedef short bf16x8 __attribute__((ext_vector_type(8)));
typedef short s16x4 __attribute__((ext_vector_type(4)));
typedef float f32x4 __attribute__((ext_vector_type(4)));
typedef float f32x16 __attribute__((ext_vector_type(16)));
typedef unsigned u32x4 __attribute__((ext_vector_type(4)));
typedef unsigned u32x2 __attribute__((ext_vector_type(2)));

constexpr int DM = 2048, NBATCH = 8, SEQ = 4096, DSEQ = 64, PAST = 4096, DFF = 5504, NADA = 9 * DM;
constexpr int MP = NBATCH * SEQ, MS = NBATCH * DSEQ, MROWS = MP + MS;
constexpr int NQKV = 6144, LD_WINAB = 6152;
constexpr float LOG2E = 1.4426950408889634f;
constexpr float QSCALE_A = 0.125f * LOG2E;
constexpr float QSCALE_B = 0.08838834764831845f * LOG2E;
constexpr float EPS = 1e-6f;

constexpr size_t OFF_Y = 0;
constexpr size_t OFF_AKP = 68157440, OFF_AVP = 101711872, OFF_BKP = 135266304, OFF_BVP = 168820736, OFF_BFP = 202375168;
constexpr size_t OFF_CKP = 202637312, OFF_CVP = 211025920;
constexpr size_t OFF_AKS = 219414528, OFF_AVS = 219938816, OFF_BKS = 220463104, OFF_BVS = 220987392, OFF_BFS = 221511680;
constexpr size_t OFF_CKS = 221515776, OFF_CVS = 222564352, OUT_TOTAL = 223612928;

constexpr size_t MiB = 1u << 20;
constexpr size_t WS_CTL = 0, CTL_BYTES = 1 * MiB;
constexpr size_t SZ_WFI = (size_t)11008 * 2048 * 2, SZ_WFO = (size_t)2048 * 5504 * 2;
constexpr size_t WS_WFI = 1 * MiB;
constexpr size_t WS_WFO = WS_WFI + 4 * SZ_WFI;
constexpr size_t WS_WINAB = WS_WFO + 4 * SZ_WFO;
constexpr size_t WS_WOUTAB = WS_WINAB + 24 * MiB;
constexpr size_t WS_WINC = WS_WOUTAB + 8 * MiB;
constexpr size_t WS_WOUTC = WS_WINC + 24 * MiB;
constexpr size_t WS_H = WS_WOUTC + 8 * MiB;
constexpr size_t WS_BIG = WS_H + 130 * MiB;
constexpr size_t WS_ATT = WS_BIG + 390 * MiB;
constexpr size_t WS_MODP = WS_ATT + 130 * MiB;
constexpr size_t WS_MODS = WS_MODP + 18 * MiB;
constexpr size_t WS_FP = WS_MODS + 3 * MiB;
constexpr size_t WS_FS = WS_FP + 1 * MiB;
constexpr size_t WS_O1 = WS_FS + 2 * MiB;
constexpr size_t WS_PART = WS_O1 + 32 * MiB;
constexpr size_t WS_XB = WS_PART + 60 * MiB;
constexpr size_t WS_END = WS_XB + 130 * MiB;

constexpr int CW_BAR = 4096;
constexpr int CW_Q0 = 16384, CW_Q1 = 16384 + 64;
constexpr int CW_KMX = 16384 + 256, CW_KDONE = 16384 + 512;

constexpr int RING_BYTES = 131072;
constexpr int LDSCTL_OFF = RING_BYTES, MISC_OFF = LDSCTL_OFF + 320, PTAB_OFF = LDSCTL_OFF + 1024;
constexpr int LDS_BYTES = 147456;

#define LDS_WAIT() asm volatile("s_waitcnt lgkmcnt(0)" ::: "memory")
#define VM_WAIT() asm volatile("s_waitcnt vmcnt(0)" ::: "memory")
#define SBAR() __builtin_amdgcn_sched_barrier(0)

__device__ __forceinline__ int fresh_tid(int wave_s) { asm volatile("" : "+s"(wave_s)); int l;
    asm volatile("v_mbcnt_lo_u32_b32 %0, -1, 0\n\tv_mbcnt_hi_u32_b32 %0, -1, %0" : "=v"(l));
    return wave_s * 64 + l; }
__device__ __forceinline__ int fresh_s(int x) { asm volatile("" : "+s"(x)); return x; }
__device__ __forceinline__ unsigned cvtpk(float lo, float hi) { unsigned r; asm volatile("v_cvt_pk_bf16_f32 %0, %1, %2" : "=v"(r) : "v"(lo), "v"(hi)); return r; }
__device__ __forceinline__ bf16x8 pack8(f32x4 a, f32x4 b) {
    u32x4 w = {cvtpk(a[0], a[1]), cvtpk(a[2], a[3]), cvtpk(b[0], b[1]), cvtpk(b[2], b[3])};
    return *reinterpret_cast<bf16x8*>(&w);
}
__device__ __forceinline__ float wave_sum(float v) {
#pragma unroll
    for (int o = 1; o < 64; o <<= 1) v += __shfl_xor(v, o);
    return v;
}

namespace pg8 {
#define PG8_LAS __attribute__((address_space(3)))
constexpr int BM = 256, BK = 64, HALF = 128, HTB = HALF * BK * 2, STAGE_BYTES = 8 * HTB, NXCD = 8, WGM = 8;
__host__ __device__ __forceinline__ int lds_byte(int r, int c) { const int st = (r >> 4) * 2 + (c >> 5), rr = r & 15, cc = c & 31, ob = rr * 64 + cc * 2; return st * 1024 + (ob ^ (((ob >> 9) & 1) << 5)); }
__host__ __device__ __forceinline__ void stage_rc(int b, int& R, int& C) { const int st = b / 1024, sb = b % 1024, swz = sb ^ (((sb >> 9) & 1) << 5); R = (st >> 1) * 16 + swz / 64; C = (st & 1) * 32 + (swz % 64) / 2; }
__host__ __device__ __forceinline__ int perm32(int rho) { const int n = rho >> 4, i = rho & 15; return 8 * (i >> 2) + 4 * n + (i & 3); }
struct Unit { int pm, pn, kofs, nt, part; };
struct Gemm { const bf16_t* A; const bf16_t* Bt; int M, N, K; };
struct StaticOrder {
    int nM, nN, nwg, G, c, ntk, wgm;
    __host__ __device__ __forceinline__ void init(int M, int N, int G_, int c_) { nM = M / BM; nN = N / BM; nwg = nM * nN; G = G_; c = c_; ntk = 0; wgm = 4; }
    __host__ __device__ __forceinline__ bool next(int i, Unit& u) const {
        const long L = (long)i * G + c; if (L >= nwg) return false;
        int wgid = (int)L; { const int q = nwg / NXCD, r = nwg % NXCD, xcd = wgid % NXCD, off = wgid / NXCD; wgid = (xcd < r ? xcd * (q + 1) : r * (q + 1) + (xcd - r) * q) + off; }
        const int nig = wgm * nN, gid = wgid / nig, fm = gid * wgm, gsz = (nM - fm) < wgm ? (nM - fm) : wgm;
        u.pm = fm + ((wgid % nig) % gsz); u.pn = (wgid % nig) / gsz; u.kofs = 0; u.nt = ntk; u.part = -1; return true;
    }
    __device__ __forceinline__ void a_ready(const Unit&) const {}
    __device__ __forceinline__ void done(const Unit&) const {}
};
struct SplitOrder {
    StaticOrder so; int S, nitems, base, rem, G, c, npre, nmine;
    __device__ __forceinline__ void init(int Kfull, int N, int S_, int G_, int c_) { so.init(MP, N, G_, c_); so.ntk = Kfull / BK; if (N / BM == 8) so.wgm = 4; S = S_; nitems = 2 * (N / BM) * S; const int chunks = Kfull / 128; base = chunks / S; rem = chunks % S; G = G_; c = c_;
        npre = ((c & 1) && c < nitems) ? 1 : 0; nmine = (so.nwg > c) ? (so.nwg - 1 - c) / G + 1 : 0; }
    __device__ __forceinline__ bool next(int i, Unit& u) const {
        const int j = i - npre;
        if (j >= 0 && j < nmine) return so.next(j, u);
        if (c >= nitems || !((npre && i == 0) || (!npre && j == nmine))) return false;
        const int unit = c / S, s = c % S, start = s * base + (s < rem ? s : rem), len = base + (s < rem ? 1 : 0);
        u.pm = MP / BM + unit / (so.nN); u.pn = unit % so.nN; u.kofs = start * 128; u.nt = len * 2; u.part = s; return true;
    }
    __device__ __forceinline__ void a_ready(const Unit&) const {}
    __device__ __forceinline__ void done(const Unit&) const {}
};
template <class Epi, class Sched, bool ALIGN_EPI = false, bool SP2 = false>
__device__ __forceinline__ void gemm_phase(PG8_LAS unsigned char* lds, const Gemm g, const Sched& S, const Epi& E, int wave_s) {
    const int tid = fresh_tid(wave_s), wid = __builtin_amdgcn_readfirstlane(tid >> 6), lane = tid & 63, wr = wid >> 2, wc = wid & 3, fr = lane & 15, fq = lane >> 4;
    const int K = g.K;
    unsigned voffA[2], voffB[2];
#pragma unroll
    for (int i = 0; i < 2; ++i) { int R, C; stage_rc(tid * 16 + i * 8192, R, C); const int Rb = Epi::PERM ? ((R & ~31) + perm32(R & 31)) : R;
        voffA[i] = (unsigned)(R * K + C) * 2u; voffB[i] = (unsigned)(Rb * K + C) * 2u; }
    const size_t kstep = (size_t)(BK * 2);
    const size_t hstep = (size_t)HALF * K * 2;
    const size_t tstep = 2 * hstep;
    const unsigned ldsw = (unsigned)wid * 1024u;
    const int aoff = lds_byte(wr * 64 + fr, fq * 8), boff = lds_byte(wc * 32 + fr, fq * 8);
#define PG8_SA(b, h) (((b) * 2 + (h)) * HTB)
#define PG8_SB(b, h) ((4 + (b) * 2 + (h)) * HTB)
#define PG8_STAGE(bufoff, gbase, voff) do { _Pragma("unroll") for (int _i = 0; _i < 2; ++_i) \
        __builtin_amdgcn_global_load_lds((const unsigned*)((const char*)(gbase) + (voff)[_i]), (PG8_LAS unsigned*)(lds + (bufoff) + ldsw + _i * 8192), 16, 0, 0); } while (0)
#define PG8_LDA(dst, b, h) do { _Pragma("unroll") for (int m = 0; m < 4; ++m) _Pragma("unroll") for (int k = 0; k < 2; ++k) dst[m][k] = *(const PG8_LAS bf16x8*)(lds + PG8_SA(b, h) + aoff + m * 2048 + k * 1024); } while (0)
#define PG8_LDB(dst, b, h) do { _Pragma("unroll") for (int n = 0; n < 2; ++n) _Pragma("unroll") for (int k = 0; k < 2; ++k) dst[n][k] = *(const PG8_LAS bf16x8*)(lds + PG8_SB(b, h) + boff + n * 2048 + k * 1024); } while (0)
#define PG8_MMA(ai, bj, At, Bt) do { __builtin_amdgcn_s_setprio(1); _Pragma("unroll") for (int m = 0; m < 4; ++m) _Pragma("unroll") for (int n = 0; n < 2; ++n) _Pragma("unroll") for (int k = 0; k < 2; ++k) \
        acc[ai][bj][m][n] = __builtin_amdgcn_mfma_f32_16x16x32_bf16(Bt[n][k], At[m][k], acc[ai][bj][m][n], 0, 0, 0); __builtin_amdgcn_s_setprio(0); } while (0)
#define PG8_WAIT_V(n) asm volatile("s_waitcnt vmcnt(" #n ")" ::: "memory")
#define PG8_WAIT_L(n) asm volatile("s_waitcnt lgkmcnt(" #n ")" ::: "memory")
#define PG8_BAR __builtin_amdgcn_s_barrier()
#define PG8_SCHED __builtin_amdgcn_sched_barrier(0)
    Unit cur, nxt; int ui = 0;
    if (!S.next(0, cur)) return;
    f32x4 acc[2][2][4][2];
#pragma unroll
    for (int a = 0; a < 2; ++a)
#pragma unroll
        for (int b = 0; b < 2; ++b)
#pragma unroll
            for (int m = 0; m < 4; ++m)
#pragma unroll
                for (int n = 0; n < 2; ++n) acc[a][b][m][n] = (f32x4){0.f, 0.f, 0.f, 0.f};
    bf16x8 At[4][2], B0[2][2], B1[2][2];
    int nt = cur.nt;
    const char* cA = (const char*)g.A + (size_t)cur.pm * tstep + (size_t)cur.kofs * 2; const char* cB = (const char*)g.Bt + (size_t)cur.pn * tstep + (size_t)cur.kofs * 2;
    S.a_ready(cur);
    if constexpr (SP2) {
        PG8_STAGE(PG8_SB(0, 0), cB, voffB); PG8_STAGE(PG8_SB(0, 1), cB + hstep, voffB); PG8_STAGE(PG8_SA(0, 0), cA, voffA); PG8_STAGE(PG8_SA(0, 1), cA + hstep, voffA);
        if (wr == 1) PG8_BAR;
        PG8_WAIT_V(2); PG8_BAR;
        PG8_STAGE(PG8_SB(1, 0), cB + kstep, voffB); PG8_STAGE(PG8_SA(1, 0), cA + kstep, voffA); PG8_STAGE(PG8_SB(1, 1), cB + hstep + kstep, voffB);
        PG8_WAIT_V(6); PG8_BAR;
    } else {
        PG8_STAGE(PG8_SB(0, 0), cB, voffB); PG8_STAGE(PG8_SA(0, 0), cA, voffA); PG8_STAGE(PG8_SB(0, 1), cB + hstep, voffB); PG8_STAGE(PG8_SA(0, 1), cA + hstep, voffA);
        if (wr == 1) PG8_BAR;
        PG8_WAIT_V(4); PG8_BAR;
        PG8_STAGE(PG8_SB(1, 0), cB + kstep, voffB); PG8_STAGE(PG8_SA(1, 0), cA + kstep, voffA); PG8_STAGE(PG8_SB(1, 1), cB + hstep + kstep, voffB);
        PG8_WAIT_V(6); PG8_BAR;
    }
    for (;;) {
        const bool has_next = S.next(ui + 1, nxt);
        const char* nA = has_next ? (const char*)g.A + (size_t)nxt.pm * tstep + (size_t)nxt.kofs * 2 : cA; const char* nB = has_next ? (const char*)g.Bt + (size_t)nxt.pn * tstep + (size_t)nxt.kofs * 2 : cB;
        for (int t = 0; t < nt; t += 2) {
            const bool last = (t == nt - 2);
            const char* a1 = cA + (size_t)(t + 1) * kstep;
            const char* a2 = last ? nA : cA + (size_t)(t + 2) * kstep; const char* b2 = last ? nB : cB + (size_t)(t + 2) * kstep;
            const char* a3 = a2 + kstep; const char* b3 = b2 + kstep;
            if (last && has_next) S.a_ready(nxt);
            if constexpr (SP2) {
            PG8_LDB(B0, 0, 0); PG8_LDB(B1, 0, 1); PG8_SCHED; PG8_LDA(At, 0, 0); PG8_STAGE(PG8_SA(1, 1), a1 + hstep, voffA);
            PG8_WAIT_V(8); PG8_WAIT_L(0); PG8_BAR; PG8_MMA(0, 0, At, B0); PG8_MMA(0, 1, At, B1); PG8_BAR; PG8_SCHED;
            PG8_LDA(At, 0, 1); PG8_STAGE(PG8_SB(0, 0), b2, voffB); PG8_STAGE(PG8_SB(0, 1), b2 + hstep, voffB); PG8_STAGE(PG8_SA(0, 0), a2, voffA);
            PG8_WAIT_V(8); PG8_WAIT_L(0); PG8_BAR; PG8_MMA(1, 0, At, B0); PG8_MMA(1, 1, At, B1); PG8_BAR; PG8_SCHED;
            PG8_LDB(B0, 1, 0); PG8_LDB(B1, 1, 1); PG8_SCHED; PG8_LDA(At, 1, 0); PG8_STAGE(PG8_SA(0, 1), a2 + hstep, voffA);
            PG8_WAIT_V(8); PG8_WAIT_L(0); PG8_BAR; PG8_MMA(0, 0, At, B0); PG8_MMA(0, 1, At, B1); PG8_BAR; PG8_SCHED;
            PG8_LDA(At, 1, 1); PG8_STAGE(PG8_SB(1, 0), b3, voffB); PG8_STAGE(PG8_SB(1, 1), b3 + hstep, voffB); PG8_STAGE(PG8_SA(1, 0), a3, voffA);
            PG8_WAIT_V(8); PG8_WAIT_L(0); PG8_BAR; PG8_MMA(1, 0, At, B0); PG8_MMA(1, 1, At, B1); PG8_BAR; PG8_SCHED;
            } else {
            PG8_LDB(B0, 0, 0); PG8_SCHED; PG8_LDA(At, 0, 0); PG8_STAGE(PG8_SA(1, 1), a1 + hstep, voffA);
            PG8_WAIT_L(8); PG8_BAR; PG8_WAIT_L(0); PG8_MMA(0, 0, At, B0); PG8_BAR; PG8_SCHED;
            PG8_LDB(B1, 0, 1); PG8_STAGE(PG8_SB(0, 0), b2, voffB);
            PG8_BAR; PG8_WAIT_L(0); PG8_MMA(0, 1, At, B1); PG8_BAR;
            PG8_LDA(At, 0, 1); PG8_STAGE(PG8_SA(0, 0), a2, voffA);
            PG8_BAR; PG8_WAIT_L(0); PG8_MMA(1, 0, At, B0); PG8_BAR; PG8_SCHED;
            PG8_STAGE(PG8_SB(0, 1), b2 + hstep, voffB);
            PG8_WAIT_V(6); PG8_BAR; PG8_MMA(1, 1, At, B1); PG8_BAR;
            PG8_LDB(B0, 1, 0); PG8_SCHED; PG8_LDA(At, 1, 0); PG8_STAGE(PG8_SA(0, 1), a2 + hstep, voffA);
            PG8_WAIT_L(8); PG8_BAR; PG8_WAIT_L(0); PG8_MMA(0, 0, At, B0); PG8_BAR; PG8_SCHED;
            PG8_LDB(B1, 1, 1); PG8_STAGE(PG8_SB(1, 0), b3, voffB);
            PG8_BAR; PG8_WAIT_L(0); PG8_MMA(0, 1, At, B1); PG8_BAR;
            PG8_LDA(At, 1, 1); PG8_STAGE(PG8_SA(1, 0), a3, voffA);
            PG8_BAR; PG8_WAIT_L(0); PG8_MMA(1, 0, At, B0); PG8_BAR; PG8_SCHED;
            PG8_STAGE(PG8_SB(1, 1), b3 + hstep, voffB);
            PG8_WAIT_V(6); PG8_BAR; PG8_MMA(1, 1, At, B1); PG8_BAR;
            }
        }
        if constexpr (ALIGN_EPI) { if (wr == 0) PG8_BAR; }
        E(acc, cur, wr, wc, fr, fq);
        if (!has_next) break;
#pragma unroll
        for (int a = 0; a < 2; ++a)
#pragma unroll
            for (int b = 0; b < 2; ++b)
#pragma unroll
                for (int m = 0; m < 4; ++m)
#pragma unroll
                    for (int n = 0; n < 2; ++n) acc[a][b][m][n] = (f32x4){0.f, 0.f, 0.f, 0.f};
        cur = nxt; cA = nA; cB = nB; ++ui; nt = cur.nt;
        if constexpr (ALIGN_EPI) { if (wr == 1) PG8_BAR; }
    }
    PG8_WAIT_V(0);
    if constexpr (!ALIGN_EPI) { if (wr == 0) PG8_BAR; }
    PG8_BAR;
#undef PG8_SA
#undef PG8_SB
#undef PG8_STAGE
#undef PG8_LDA
#undef PG8_LDB
#undef PG8_MMA
#undef PG8_WAIT_V
#undef PG8_WAIT_L
#undef PG8_BAR
#undef PG8_SCHED
}
}

struct EpiSwiGLU {
    static constexpr bool PERM = true;
    bf16_t* O;
    __device__ __forceinline__ void operator()(const f32x4 (&acc)[2][2][4][2], const pg8::Unit& u, int wr, int wc, int fr, int fq) const {
        const int row0 = u.pm * 256 + wr * 64 + fr, col0 = u.pn * 128 + wc * 32 + 8 * fq;
#pragma unroll
        for (int ai = 0; ai < 2; ++ai)
#pragma unroll
            for (int m = 0; m < 4; ++m) {
                bf16_t* rowp = O + (size_t)(row0 + ai * 128 + m * 16) * DFF + col0;
                float v[8];
#pragma unroll
                for (int n = 0; n < 2; ++n)
#pragma unroll
                    for (int j = 0; j < 4; ++j) {
                        const float t = acc[ai][0][m][n][j], uu = acc[ai][1][m][n][j];
                        v[n * 4 + j] = (t * uu) * __builtin_amdgcn_rcpf(1.0f + __builtin_amdgcn_exp2f(t));
                    }
                u32x4 w; w.x = cvtpk(v[0], v[1]); w.y = cvtpk(v[2], v[3]); w.z = cvtpk(v[4], v[5]); w.w = cvtpk(v[6], v[7]);
                *(u32x4*)rowp = w;
            }
    }
};
struct EpiResGate {
    static constexpr bool PERM = true;
    const float* xin_p;
    bf16_t* xb;
    const float* gate;
    float coef;
    float* part;
    __device__ __forceinline__ void operator()(const f32x4 (&acc)[2][2][4][2], const pg8::Unit& u, int wr, int wc, int fr, int fq) const {
        const int row0 = u.pm * 256 + wr * 64 + fr, col0 = u.pn * 256 + wc * 32 + 8 * fq;
        if (u.part >= 0) {
            float* pp = part + ((size_t)u.part * MS + (row0 - MP)) * DM + col0;
#pragma unroll
            for (int ai = 0; ai < 2; ++ai)
#pragma unroll
                for (int m = 0; m < 4; ++m)
#pragma unroll
                    for (int bj = 0; bj < 2; ++bj)
#pragma unroll
                        for (int n = 0; n < 2; ++n) *(f32x4*)(pp + (size_t)(ai * 128 + m * 16) * DM + bj * 128 + n * 4) = acc[ai][bj][m][n];
            return;
        }
        const int modrow = u.pm >> 4;
        const float* gp = gate + (size_t)modrow * NADA + col0;
        f32x4 gv[2][2];
#pragma unroll
        for (int bj = 0; bj < 2; ++bj)
#pragma unroll
            for (int n = 0; n < 2; ++n) gv[bj][n] = *(const f32x4*)(gp + bj * 128 + n * 4) * coef;
#pragma unroll
        for (int ai = 0; ai < 2; ++ai)
#pragma unroll
            for (int m = 0; m < 4; ++m) {
                const size_t off = (size_t)(row0 + ai * 128 + m * 16) * DM + col0;
#pragma unroll
                for (int bj = 0; bj < 2; ++bj) {
                    f32x4 x0, x1;
                    if (xin_p) { x0 = *(const f32x4*)(xin_p + off + bj * 128); x1 = *(const f32x4*)(xin_p + off + bj * 128 + 4); }
                    else { const u32x4 w = *(const u32x4*)(xb + off + bj * 128);
                        x0 = (f32x4){__uint_as_float(w.x << 16), __uint_as_float(w.x & 0xffff0000u), __uint_as_float(w.y << 16), __uint_as_float(w.y & 0xffff0000u)};
                        x1 = (f32x4){__uint_as_float(w.z << 16), __uint_as_float(w.z & 0xffff0000u), __uint_as_float(w.w << 16), __uint_as_float(w.w & 0xffff0000u)}; }
                    x0 += gv[bj][0] * acc[ai][bj][m][0]; x1 += gv[bj][1] * acc[ai][bj][m][1];
                    u32x4 o; o.x = cvtpk(x0[0], x0[1]); o.y = cvtpk(x0[2], x0[3]); o.z = cvtpk(x1[0], x1[1]); o.w = cvtpk(x1[2], x1[3]);
                    *(u32x4*)(xb + off + bj * 128) = o;
                }
            }
    }
};
struct EpiQKV {
    static constexpr bool PERM = true;
    bf16_t* O;
    float* out;
    int layer1;
    float* part;
    __device__ __forceinline__ void operator()(const f32x4 (&acc)[2][2][4][2], const pg8::Unit& u, int wr, int wc, int fr, int fq) const {
        if (u.part >= 0) {
            float* pp = part + ((size_t)u.part * MS + (u.pm * 256 - MP + wr * 64 + fr)) * NQKV + u.pn * 256 + wc * 32 + 8 * fq;
#pragma unroll
            for (int ai = 0; ai < 2; ++ai)
#pragma unroll
                for (int m = 0; m < 4; ++m)
#pragma unroll
                    for (int bj = 0; bj < 2; ++bj)
#pragma unroll
                        for (int n = 0; n < 2; ++n) *(f32x4*)(pp + (size_t)(ai * 128 + m * 16) * NQKV + bj * 128 + n * 4) = acc[ai][bj][m][n];
            return;
        }
        const int sh = layer1 ? 3 : 2;
        const int sec = u.pn >> sh, colw = (u.pn & ((1 << sh) - 1)) * 256, ldf = 256 << sh;
        const int row0 = u.pm * 256 + wr * 64 + fr, cw = wc * 32 + 8 * fq;
        const bool samp = u.pm >= 128;
        size_t fo = 0;
        if (!layer1) { if (sec == 1) fo = samp ? OFF_AKS : OFF_AKP; else if (sec == 2) fo = samp ? OFF_AVS : OFF_AVP; else if (sec == 4) fo = samp ? OFF_BKS : OFF_BKP; else if (sec == 5) fo = samp ? OFF_BVS : OFF_BVP; }
        else { if (sec == 1) fo = samp ? OFF_CKS : OFF_CKP; else if (sec == 2) fo = samp ? OFF_CVS : OFF_CVP; }
        float* fdst = nullptr;
        if (fo) {
            if (samp) fdst = out + fo + (size_t)(u.pm * 256 - MP) * ldf;
            else if (!layer1) fdst = out + fo + (size_t)(u.pm * 256) * ldf;
            else if ((u.pm & 15) >= 14) { const int b = u.pm >> 4; fdst = out + fo + (size_t)(u.pm * 256 - (b + 1) * 3584) * ldf; }
        }
#pragma unroll
        for (int ai = 0; ai < 2; ++ai)
#pragma unroll
            for (int m = 0; m < 4; ++m) {
                const int rl = ai * 128 + m * 16;
                bf16_t* rowp = O + (size_t)(row0 + rl) * NQKV + u.pn * 256 + cw;
#pragma unroll
                for (int bj = 0; bj < 2; ++bj) {
                    const f32x4 v0 = acc[ai][bj][m][0], v1 = acc[ai][bj][m][1];
                    u32x4 w; w.x = cvtpk(v0[0], v0[1]); w.y = cvtpk(v0[2], v0[3]); w.z = cvtpk(v1[0], v1[1]); w.w = cvtpk(v1[2], v1[3]);
                    *(u32x4*)(rowp + bj * 128) = w;
                    if (fdst) { float* fr_ = fdst + (size_t)(wr * 64 + fr + rl) * ldf + colw + bj * 128 + cw;
                        __builtin_nontemporal_store(v0, (f32x4*)fr_); __builtin_nontemporal_store(v1, (f32x4*)(fr_ + 4)); }
                }
            }
    }
};

#define XB_TMO      128
#define XB_XCNT(j)  (256  + 64 * (j))
#define XB_XSUB(j)  (1280 + 64 * (j))
#define XB_XGEN(j)  (2304 + 64 * (j))
#define XB_TOP      3328
#define XB_TOPGEN   3392
#define XCD_BAR_WORDS 3456
#define XB_SPIN_CAP (1u << 18)
__device__ __forceinline__ unsigned xb_ld(unsigned* p)              { return __hip_atomic_load(p, __ATOMIC_RELAXED, __HIP_MEMORY_SCOPE_AGENT); }
__device__ __forceinline__ unsigned xb_add(unsigned* p, unsigned v) { return __hip_atomic_fetch_add(p, v, __ATOMIC_RELAXED, __HIP_MEMORY_SCOPE_AGENT); }
__device__ __forceinline__ unsigned xb_xcc_id() { return (unsigned)__builtin_amdgcn_s_getreg((3 << 11) | 20) & 0xFu; }
#define XB_SPIN(cond, bar) do { unsigned _sp = 0; while (cond) { __builtin_amdgcn_s_sleep(1); \
    if ((++_sp & 255u) == 0u) { if (xb_ld(&(bar)[XB_TMO])) break; if (_sp > XB_SPIN_CAP) { atomicAdd(&(bar)[XB_TMO], 1u); break; } } } } while (0)
struct XcdBarrier { unsigned* bar; unsigned x; volatile LAS unsigned* st; };
__device__ __forceinline__ XcdBarrier xcd_barrier_post(unsigned* bar, volatile LAS unsigned* st, int tid) {
    XcdBarrier b; b.bar = bar; b.x = xb_xcc_id(); b.st = st;
    if (tid == 0) (void)xb_add(&bar[XB_XCNT(b.x)], 1u);
    return b;
}
__device__ __forceinline__ void xcd_barrier_complete(unsigned* bar, unsigned x, unsigned& nloc, unsigned& nx) {
    const unsigned G = gridDim.x * gridDim.y * gridDim.z;
    unsigned sum, cnt, mine, sp = 0u;
    for (;;) {
        sum = 0u; cnt = 0u; mine = 0u;
#pragma unroll
        for (unsigned j = 0; j < 16; ++j) { const unsigned c = xb_ld(&bar[XB_XCNT(j)]); sum += c; cnt += (c > 0u) ? 1u : 0u; }
        mine = xb_ld(&bar[XB_XCNT(x)]);
        if (sum == G) break;
        __builtin_amdgcn_s_sleep(1);
        if ((++sp & 255u) == 0u) { if (xb_ld(&bar[XB_TMO])) break; if (sp > XB_SPIN_CAP) { atomicAdd(&bar[XB_TMO], 1u); break; } }
    }
    nloc = mine > 0u ? mine : 1u; nx = cnt > 0u ? cnt : 1u;
}
__device__ __forceinline__ void xcd_barrier(const XcdBarrier& b, int tid) {
    asm volatile("s_waitcnt vmcnt(0)" ::: "memory");
    __syncthreads();
    if (tid == 0) {
        unsigned* bar = b.bar; asm volatile("" : "+s"(bar));
        __builtin_amdgcn_s_waitcnt(0);
        unsigned nloc = b.st[0], nx = b.st[1];
        if (nloc == 0u) { xcd_barrier_complete(bar, b.x, nloc, nx); b.st[0] = nloc; b.st[1] = nx; }
        const unsigned old = xb_add(&bar[XB_XSUB(b.x)], 1u);
        const unsigned gen = old / nloc;
        if (old + 1u == (gen + 1u) * nloc) {
            __builtin_amdgcn_fence(__ATOMIC_RELEASE, "agent");
            asm volatile("s_waitcnt vmcnt(0)" ::: "memory");
            const unsigned og = xb_add(&bar[XB_TOP], 1u);
            const unsigned tg = og / nx;
            if (og + 1u == (tg + 1u) * nx) xb_add(&bar[XB_TOPGEN], 1u);
            else XB_SPIN(xb_ld(&bar[XB_TOPGEN]) == tg, bar);
            __builtin_amdgcn_fence(__ATOMIC_ACQUIRE, "agent");
            xb_add(&bar[XB_XGEN(b.x)], 1u);
            asm volatile("s_waitcnt vmcnt(0)" ::: "memory");
        } else {
            XB_SPIN(xb_ld(&bar[XB_XGEN(b.x)]) == gen, bar);
            __builtin_amdgcn_fence(__ATOMIC_ACQUIRE, "agent");
            asm volatile("s_waitcnt vmcnt(0)" ::: "memory");
        }
    }
    __syncthreads();
}

__device__ __forceinline__ void transpose_block(const float* W, int ldw, int K, bf16_t* WT, int k0, int n0, int swiglu, int lane) {
    const int a = lane & 15, g = lane >> 4;
    const float* src = W + (size_t)(k0 + 16 * g) * ldw + n0 + 4 * a;
    f32x4 v[16];
#pragma unroll
    for (int kk = 0; kk < 16; ++kk) v[kk] = *(const f32x4*)(src + (size_t)kk * ldw);
#pragma unroll
    for (int j = 0; j < 4; ++j) {
        const int n = n0 + 4 * a + j;
        int R = n;
        if (swiglu == 1) { R = (n < DFF) ? ((n >> 7) * 256 + (n & 127)) : (((n - DFF) >> 7) * 256 + 128 + ((n - DFF) & 127));
            const float sc = (n < DFF) ? -LOG2E : -1.0f / LOG2E;
#pragma unroll
            for (int kk = 0; kk < 16; ++kk) v[kk][j] *= sc; }
        if (swiglu >= 2) {
            const float sc = (swiglu == 2) ? ((n < 1024) ? QSCALE_A : ((n >= 3072 && n < 4096) ? QSCALE_B : 1.0f)) : ((n < 2048) ? QSCALE_B : 1.0f);
#pragma unroll
            for (int kk = 0; kk < 16; ++kk) v[kk][j] *= sc; }
        u32x4 w0, w1;
        w0.x = cvtpk(v[0][j], v[1][j]); w0.y = cvtpk(v[2][j], v[3][j]); w0.z = cvtpk(v[4][j], v[5][j]); w0.w = cvtpk(v[6][j], v[7][j]);
        w1.x = cvtpk(v[8][j], v[9][j]); w1.y = cvtpk(v[10][j], v[11][j]); w1.z = cvtpk(v[12][j], v[13][j]); w1.w = cvtpk(v[14][j], v[15][j]);
        bf16_t* dst = WT + (size_t)R * K + k0 + 16 * g;
        *(u32x4*)dst = w0; *(u32x4*)(dst + 8) = w1;
    }
}
struct InPtrs { const float* p[29]; };
__device__ __forceinline__ const float* inp(LAS unsigned char* lds, int i) {
    int off = PTAB_OFF + 8 * i; asm volatile("" : "+v"(off));
    const unsigned long long v = *(volatile LAS unsigned long long*)(lds + off);
    const unsigned lo = __builtin_amdgcn_readfirstlane((unsigned)v), hi = __builtin_amdgcn_readfirstlane((unsigned)(v >> 32));
    return (const float*)(((unsigned long long)hi << 32) | lo);
}

__device__ __forceinline__ void prologue_phase(unsigned char* ws, LAS unsigned char* lds, int G, int wg, int tid, int wave, int lane) {
    const float* w_ada = inp(lds, 11); const float* c_p = inp(lds, 9); const float* c_s = inp(lds, 10);
    float* modp = (float*)(ws + WS_MODP);
    LAS float* sct = (LAS float*)lds;
    LAS f32x4* red = (LAS f32x4*)(lds + 16384);
    for (int u = wg; u < 1152; u += G) {
        const int l = u / 576, r = u % 576, cb = r >> 3, k8 = r & 7, k0 = k8 * 256;
        __syncthreads();
        if (tid < 256) {
            const int k = k0 + tid;
#pragma unroll
            for (int rr = 0; rr < 16; ++rr) { const float c = (rr < 8) ? c_p[rr * DM + k] : c_s[(rr - 8) * DM + k];
                sct[tid * 16 + rr] = c / (1.0f + __expf(-c)); }
        }
        __syncthreads();
        f32x4 acc[16];
#pragma unroll
        for (int rr = 0; rr < 16; ++rr) acc[rr] = (f32x4){0.f, 0.f, 0.f, 0.f};
        const float* wp = w_ada + ((size_t)l * DM + k0 + wave * 32) * NADA + cb * 256 + 4 * lane;
#pragma unroll 4
        for (int kk = 0; kk < 32; ++kk) {
            const f32x4 wv = *(const f32x4*)(wp + (size_t)kk * NADA);
            const LAS f32x4* sp = (const LAS f32x4*)(sct + (wave * 32 + kk) * 16);
            const f32x4 s0 = sp[0], s1 = sp[1], s2 = sp[2], s3 = sp[3];
#pragma unroll
            for (int e = 0; e < 4; ++e) { acc[e] += wv * s0[e]; acc[4 + e] += wv * s1[e]; acc[8 + e] += wv * s2[e]; acc[12 + e] += wv * s3[e]; }
        }
#pragma unroll
        for (int p = 0; p < 2; ++p) {
#pragma unroll
            for (int i = 0; i < 8; ++i) red[(wave * 8 + i) * 64 + lane] = acc[p * 8 + i];
            __syncthreads();
            { const int i = tid >> 6, ln = tid & 63; f32x4 s = red[i * 64 + ln];
#pragma unroll
              for (int w = 1; w < 8; ++w) s += red[(w * 8 + i) * 64 + ln];
              *(f32x4*)(modp + ((size_t)((k8 * 2 + l) * 16 + p * 8 + i)) * NADA + cb * 256 + 4 * ln) = s; }
            __syncthreads();
        }
    }
    constexpr int NB_FI = 32 * 172, NB_FO = 86 * 32, NB_IN = 32 * 96, NB_OUT = 32 * 32;
    constexpr int TOT = 4 * NB_FI + 4 * NB_FO + 2 * NB_IN + 2 * NB_OUT;
    for (int gb = wg * 8 + wave; gb < TOT; gb += G * 8) {
        int g = gb; const float* W; int ldw, K, nb64, swi = 0; bf16_t* WT;
        if (g < 4 * NB_FI) { const int m = g / NB_FI; g -= m * NB_FI; W = inp(lds, 14) + (size_t)m * DM * 11008; ldw = 11008; K = DM; nb64 = 172; swi = 1; WT = (bf16_t*)(ws + WS_WFI + (size_t)m * SZ_WFI); }
        else { g -= 4 * NB_FI;
            if (g < 4 * NB_FO) { const int m = g / NB_FO; g -= m * NB_FO; W = inp(lds, 15) + (size_t)m * DFF * DM; ldw = DM; K = DFF; nb64 = 32; WT = (bf16_t*)(ws + WS_WFO + (size_t)m * SZ_WFO); }
            else { g -= 4 * NB_FO;
                if (g < NB_IN) { W = inp(lds, 16); ldw = LD_WINAB; K = DM; nb64 = 96; swi = 2; WT = (bf16_t*)(ws + WS_WINAB); }
                else { g -= NB_IN;
                    if (g < NB_OUT) { W = inp(lds, 18); ldw = DM; K = DM; nb64 = 32; WT = (bf16_t*)(ws + WS_WOUTAB); }
                    else { g -= NB_OUT;
                        if (g < NB_IN) { W = inp(lds, 25); ldw = NQKV; K = DM; nb64 = 96; swi = 3; WT = (bf16_t*)(ws + WS_WINC); }
                        else { g -= NB_IN; W = inp(lds, 26); ldw = DM; K = DM; nb64 = 32; WT = (bf16_t*)(ws + WS_WOUTC); } } } } }
        const int kb = g / nb64, nb = g % nb64;
        transpose_block(W, ldw, K, WT, kb * 64, nb * 64, swi, lane);
    }
}
__device__ __forceinline__ void mods_finalize(LAS unsigned char* lds, unsigned char* ws, int G, int wg, int tid) {
    const float* modp = (const float*)(ws + WS_MODP); float* mods = (float*)(ws + WS_MODS); const float* b_ada = inp(lds, 12);
    constexpr int NV = 2 * 16 * NADA / 4;
    for (int i = wg * 512 + tid; i < NV; i += G * 512) {
        const int e = i * 4, l = e / (16 * NADA), rem = e % (16 * NADA), r = rem / NADA, j = rem % NADA;
        f32x4 s = *(const f32x4*)(b_ada + (size_t)l * NADA + j);
#pragma unroll
        for (int k8 = 0; k8 < 8; ++k8) s += *(const f32x4*)(modp + ((size_t)((k8 * 2 + l) * 16 + r)) * NADA + j);
        *(f32x4*)(mods + e) = s;
    }
}

__device__ __forceinline__ void load_row(f32x4 (&v)[8], const float* x32, const bf16_t* xb, int lane) {
    if (x32) {
#pragma unroll
        for (int j = 0; j < 8; ++j) v[j] = *(const f32x4*)(x32 + 4 * lane + 256 * j);
    } else {
#pragma unroll
        for (int j = 0; j < 8; ++j) { const u32x2 w = *(const u32x2*)(xb + 4 * lane + 256 * j);
            v[j] = (f32x4){__uint_as_float(w.x << 16), __uint_as_float(w.x & 0xffff0000u), __uint_as_float(w.y << 16), __uint_as_float(w.y & 0xffff0000u)}; }
    }
}
struct SampleFix { const float* part; int S; const float* gate; float coef; };
__device__ __forceinline__ void sample_fix(f32x4 (&v)[8], const SampleFix& fx, int srow, bf16_t* xb_row, int lane) {
    f32x4 acc[8];
#pragma unroll
    for (int j = 0; j < 8; ++j) acc[j] = (f32x4){0.f, 0.f, 0.f, 0.f};
#pragma unroll 1
    for (int sl = 0; sl < fx.S; ++sl) { const float* pp = fx.part + ((size_t)sl * MS + srow) * DM + 4 * lane;
#pragma unroll
        for (int j = 0; j < 8; ++j) acc[j] += *(const f32x4*)(pp + 256 * j); }
    const float* gp = fx.gate + (size_t)(8 + (srow >> 6)) * NADA + 4 * lane;
#pragma unroll
    for (int j = 0; j < 8; ++j) { v[j] += *(const f32x4*)(gp + 256 * j) * fx.coef * acc[j];
        u32x2 w; w.x = cvtpk(v[j][0], v[j][1]); w.y = cvtpk(v[j][2], v[j][3]);
        *(u32x2*)(xb_row + 4 * lane + 256 * j) = w;
        v[j] = (f32x4){__uint_as_float(w.x << 16), __uint_as_float(w.x & 0xffff0000u), __uint_as_float(w.y << 16), __uint_as_float(w.y & 0xffff0000u)}; }
}
template <bool FGATE>
__device__ __forceinline__ void norm_row(f32x4 (&v)[8], bf16_t* hrow, const f32x4 (&gs)[8], const f32x4 (&sh)[8], int lane,
                                         const LAS f32x4* wfA, const LAS f32x4* wfB, const float* bf, float* fout) {
    float ss = 0.f;
#pragma unroll
    for (int j = 0; j < 8; ++j) ss += (v[j][0] * v[j][0] + v[j][1] * v[j][1]) + (v[j][2] * v[j][2] + v[j][3] * v[j][3]);
    const float rstd = 1.0f / sqrtf(wave_sum(ss) * (1.0f / DM) + EPS);
#pragma unroll
    for (int j = 0; j < 8; ++j) { v[j] = v[j] * rstd * gs[j] + sh[j];
        u32x2 w; w.x = cvtpk(v[j][0], v[j][1]); w.y = cvtpk(v[j][2], v[j][3]);
        *(u32x2*)(hrow + 4 * lane + 256 * j) = w; }
    if constexpr (FGATE) {
        f32x4 fa = {0.f, 0.f, 0.f, 0.f}, fb = {0.f, 0.f, 0.f, 0.f};
#pragma unroll
        for (int j = 0; j < 8; ++j)
#pragma unroll
            for (int e = 0; e < 4; ++e) { const f32x4 a = wfA[(j * 4 + e) * 64 + lane], b = wfB[(j * 4 + e) * 64 + lane]; fa += a * v[j][e]; fb += b * v[j][e]; }
        float z[8];
#pragma unroll
        for (int e = 0; e < 4; ++e) { z[e] = wave_sum(fa[e]); z[4 + e] = wave_sum(fb[e]); }
        float zz = z[0];
#pragma unroll
        for (int e = 1; e < 8; ++e) zz = (lane == e) ? z[e] : zz;
        if (lane < 8) { zz += bf[lane]; const float lf = fminf(zz, 0.f) - log1pf(expf(-fabsf(zz))); fout[lane] = lf; }
    }
}
template <bool FGATE>
__device__ __forceinline__ void norm_phase(const float* xp32, const float* xs32, bf16_t* xb, const float* g, const float* mods_l, int chunk, bf16_t* H,
                                           const float* wf_src, const float* bf, float* out, const SampleFix fx, LAS unsigned char* lds, int G, int wg, int tid, int wave, int lane) {
    const LAS f32x4* wfA = (const LAS f32x4*)lds; const LAS f32x4* wfB = (const LAS f32x4*)(lds + 32768);
    if constexpr (FGATE) {
        for (int c = tid; c < DM; c += 512) { const int j = c >> 8, ln = (c & 255) >> 2, e = c & 3, idx = (j * 4 + e) * 64 + ln;
            const float* s = wf_src + (size_t)c * LD_WINAB + 6144;
            ((LAS f32x4*)lds)[idx] = *(const f32x4*)s; ((LAS f32x4*)(lds + 32768))[idx] = *(const f32x4*)(s + 4); }
        __syncthreads();
    }
    f32x4 gs[8], sh[8], v[8], v2[8];
    for (int blk = wg; blk < 256; blk += G) {
        const int b = blk >> 5, r0 = b * SEQ + (blk & 31) * 128 + wave * 16;
        const float* shp = mods_l + (size_t)b * NADA + chunk * DM; const float* scp = shp + DM;
#pragma unroll
        for (int j = 0; j < 8; ++j) { const int c = 4 * lane + 256 * j; gs[j] = *(const f32x4*)(g + c) * (*(const f32x4*)(scp + c) + 1.0f); sh[j] = *(const f32x4*)(shp + c); }
        for (int i = 0; i < 16; i += 2) { const int row = r0 + i;
            load_row(v, xp32 ? xp32 + (size_t)row * DM : nullptr, xb + (size_t)row * DM, lane);
            load_row(v2, xp32 ? xp32 + (size_t)(row + 1) * DM : nullptr, xb + (size_t)(row + 1) * DM, lane);
            norm_row<FGATE>(v, H + (size_t)row * DM, gs, sh, lane, wfA, wfB, bf, FGATE ? out + OFF_BFP + (size_t)row * 8 : nullptr);
            norm_row<FGATE>(v2, H + (size_t)(row + 1) * DM, gs, sh, lane, wfA, wfB, bf, FGATE ? out + OFF_BFP + (size_t)(row + 1) * 8 : nullptr); }
    }
    for (int s = wave * G + wg; s < MS; s += 8 * G) {
        const int mr = 8 + (s >> 6);
        const float* shp = mods_l + (size_t)mr * NADA + chunk * DM; const float* scp = shp + DM;
#pragma unroll
        for (int j = 0; j < 8; ++j) { const int c = 4 * lane + 256 * j; gs[j] = *(const f32x4*)(g + c) * (*(const f32x4*)(scp + c) + 1.0f); sh[j] = *(const f32x4*)(shp + c); }
        load_row(v, xs32 ? xs32 + (size_t)s * DM : nullptr, xb + (size_t)(MP + s) * DM, lane);
        if (fx.S) sample_fix(v, fx, s, xb + (size_t)(MP + s) * DM, lane);
        norm_row<FGATE>(v, H + (size_t)(MP + s) * DM, gs, sh, lane, wfA, wfB, bf, FGATE ? out + OFF_BFS + (size_t)s * 8 : nullptr);
    }
}
__device__ __forceinline__ void final_norm_phase(bf16_t* xb, float* y, const float* g, const SampleFix fx, int G, int wg, int wave, int lane) {
    f32x4 gv[8], v[8], v2[8];
#pragma unroll
    for (int j = 0; j < 8; ++j) gv[j] = *(const f32x4*)(g + 4 * lane + 256 * j);
#define FN_ROW(V, ROW) do { float ss = 0.f; _Pragma("unroll") for (int j = 0; j < 8; ++j) ss += (V[j][0] * V[j][0] + V[j][1] * V[j][1]) + (V[j][2] * V[j][2] + V[j][3] * V[j][3]); \
        const float rstd = 1.0f / sqrtf(wave_sum(ss) * (1.0f / DM) + EPS); float* yr = y + (size_t)(ROW) * DM; \
        _Pragma("unroll") for (int j = 0; j < 8; ++j) __builtin_nontemporal_store(V[j] * rstd * gv[j], (f32x4*)(yr + 4 * lane + 256 * j)); } while (0)
    for (int row = (wg * 8 + wave) * 2; row < MP; row += G * 16) {
        load_row(v, nullptr, xb + (size_t)row * DM, lane); load_row(v2, nullptr, xb + (size_t)(row + 1) * DM, lane);
        FN_ROW(v, row); FN_ROW(v2, row + 1);
    }
    for (int s = wave * G + wg; s < MS; s += 8 * G) {
        load_row(v, nullptr, xb + (size_t)(MP + s) * DM, lane);
        if (fx.S) sample_fix(v, fx, s, xb + (size_t)(MP + s) * DM, lane);
        FN_ROW(v, MP + s);
    }
#undef FN_ROW
}

__device__ __forceinline__ void cumsum_seq(const float* s1, int n1, const float* s2, int n2, float* dst, LAS unsigned char* lds, int tid, int wave, int lane) {
    LAS double* red = (LAS double*)lds;
    const int n = n1 + n2;
    double loc[9]; double run = 0.0;
#pragma unroll
    for (int e = 0; e < 9; ++e) { const int pos = 9 * tid + e; float v = 0.f;
        if (pos < n) v = (pos < n1) ? s1[(size_t)pos * 8] : s2[(size_t)(pos - n1) * 8];
        run += (double)v; loc[e] = run; }
    double x = run;
#pragma unroll
    for (int o = 1; o < 64; o <<= 1) { const double y = __shfl_up(x, o); if (lane >= o) x += y; }
    __syncthreads();
    if (lane == 63) red[wave] = x;
    __syncthreads();
    double pre = x - run;
    for (int w = 0; w < wave; ++w) pre += red[w];
#pragma unroll
    for (int e = 0; e < 9; ++e) { const int pos = 9 * tid + e; if (pos < n) dst[pos] = (float)((pre + loc[e]) * 1.4426950408889634); }
    __syncthreads();
}

namespace att {
constexpr int SHM = 16384;
constexpr int L_V = 0, L_K = 2 * SHM, L_WS = 4 * SHM, L_TAB = L_WS + 2048, L_FK = L_TAB + 1024, L_ACT = L_FK + 512, L_END = L_ACT + 64;
constexpr float THR2 = 11.0f;
#define KSWZ(row, colB) ((row) * 256 + ((colB) ^ (((row) & 7) << 4)))
__device__ __forceinline__ int v_st(int k, int c) { const int kk = (k & ~0xC) | ((k & 4) << 1) | ((k & 8) >> 1); return ((kk >> 3) * 4 + (c >> 5)) * 512 + ((kk & 7) * 32 + (c & 31)) * 2; }
__device__ __forceinline__ int v_rd_base(int lane) { return ((lane & 3) << 3) | (((lane >> 2) & 3) << 6) | (((lane >> 4) & 1) << 5) | (((lane >> 5) & 1) << 8); }
__device__ __forceinline__ int crow(int r, int hi) { return (r & 3) + 8 * (r >> 2) + 4 * hi; }

struct Args {
    const void* K1; const void* V1; const void* K2; const void* V2;
    const bf16_t* Q; bf16_t* O;
    const float* F;
    const float* tabsrc; int tabkind;
    float* o1s; const float* subg; float lam; float kmax2;
    int ks, qs, os, nrows, qpos0, kpos0, nt, tsplit, band;
};

template <int ND0, bool K128P = false>
__device__ __forceinline__ void qkt(f32x16& p0, f32x16& p1, const f32x16& c0, const f32x16& c1, const LAS unsigned char* Kt, int r32, int hi, const bf16x8 (&qr)[ND0]) {
    p0 = c0; p1 = c1;
    const LAS unsigned char* kb[4];
#pragma unroll
    for (int dd = 0; dd < 4; ++dd) kb[dd] = K128P ? Kt + r32 * 128 + (((dd * 2 + hi) ^ ((r32 >> 1) & 7)) << 4) : Kt + KSWZ(r32, (dd * 16 + hi * 8) * 2);
#pragma unroll
    for (int d0 = 0; d0 < ND0; ++d0) { const LAS unsigned char* a = kb[d0 & 3] + (d0 >> 2) * 128;
        const bf16x8 b0 = *(const LAS bf16x8*)a;
        const bf16x8 b1 = *(const LAS bf16x8*)(a + 32 * (K128P ? 128 : 256));
        p0 = __builtin_amdgcn_mfma_f32_32x32x16_bf16(b0, qr[d0], p0, 0, 0, 0);
        p1 = __builtin_amdgcn_mfma_f32_32x32x16_bf16(b1, qr[d0], p1, 0, 0, 0); }
}
#define TRRD(p) __builtin_amdgcn_ds_read_tr16_b64_v4i16((LAS s16x4*)(p))
__device__ __forceinline__ void pv_tile(f32x16 (&o)[4], const LAS unsigned char* vb, bf16x8 pa0, bf16x8 pa1, bf16x8 pa2, bf16x8 pa3) {
    s16x4 la[4], ha[4], lb[4], hb[4];
#define PV_RD(L, H, ks) _Pragma("unroll") for (int d0 = 0; d0 < 4; ++d0) { L[d0] = TRRD(vb + d0 * 512 + (ks) * 4096); H[d0] = TRRD(vb + d0 * 512 + (ks) * 4096 + 2048); }
#define PV_MM(L, H, pa) _Pragma("unroll") for (int d0 = 0; d0 < 4; ++d0) o[d0] = __builtin_amdgcn_mfma_f32_32x32x16_bf16((bf16x8){L[d0][0], L[d0][1], L[d0][2], L[d0][3], H[d0][0], H[d0][1], H[d0][2], H[d0][3]}, pa, o[d0], 0, 0, 0);
    PV_RD(la, ha, 0) SBAR();
    PV_RD(lb, hb, 1) PV_MM(la, ha, pa0) SBAR();
    PV_RD(la, ha, 2) PV_MM(lb, hb, pa1) SBAR();
    PV_RD(lb, hb, 3) PV_MM(la, ha, pa2) SBAR();
    PV_MM(lb, hb, pa3) SBAR();
#undef PV_RD
#undef PV_MM
}
__device__ __forceinline__ int t5_bucket(int rel) {
    const int n = rel < 0 ? -rel : rel; int b;
    if (n < 8) b = n; else if (n < 12) b = 8; else if (n < 16) b = 9; else if (n < 23) b = 10; else if (n < 32) b = 11; else if (n < 46) b = 12; else if (n < 64) b = 13; else if (n < 91) b = 14; else b = 15;
    return b + (rel > 0 ? 16 : 0);
}

template <bool F32SRC, int DQK, int MODE, bool PRUNE = false>
__device__ __forceinline__ void attn_item(LAS unsigned char* lds, const Args& a, int wave_s) {
    constexpr bool DUAL = F32SRC && DQK == 64;
    constexpr int ND0 = DQK / 16, NPASS = (DQK == 64 && !DUAL) ? 2 : 1;
    constexpr bool KHALF = !F32SRC && DQK == 64;
    const int tid = fresh_tid(wave_s), wave = __builtin_amdgcn_readfirstlane(tid >> 6), lane = tid & 63, r32 = lane & 31, hi = lane >> 5;
    LAS unsigned char* V_lds = lds + L_V; LAS unsigned char* K_lds = lds + L_K;
    LAS float* li_l = (LAS float*)(lds + L_WS) + wave * 64; LAS float* al_l = li_l + 32;
    LAS float* tab = (LAS float*)(lds + L_TAB); LAS float* fk = (LAS float*)(lds + L_FK);
    const int rg = DUAL ? (wave & 1) : wave, hfw = DUAL ? (wave >> 1) : 0;
    const bool wact = DUAL ? (wave < 4) : (wave * 32 < a.nrows);
    const int wq0 = a.qpos0 + rg * 32, cq = wq0 >> 6, qpos = wq0 + r32;
    const int sr = tid >> 4, sc = (tid & 15) * 8;
    const int kws = KSWZ(sr, sc * 2), vst0 = v_st(sr, sc), vst1 = v_st(32 + sr, sc);
    const LAS unsigned char* vb = V_lds + v_rd_base(lane);
    bf16x8 sk0, sk1, sv0, sv1; f32x4 fk0a, fk0b, fk1a, fk1b, fv0a, fv0b, fv1a, fv1b; float ff = 0.f;
    int vdo[2] = {0, 0}, kdo = 0;
    if constexpr (KHALF) {
#pragma unroll
        for (int j = 0; j < 2; ++j) { const int P = (wave * 2 + j) * 64 + lane; const int kk = ((P >> 7) << 3) | ((P >> 2) & 7), kr = (kk & ~0xC) | ((kk & 4) << 1) | ((kk & 8) >> 1), c = ((P >> 5) & 3) * 32 + (P & 3) * 8; vdo[j] = kr * a.ks + c; }
        { const int P = wave * 64 + lane, r = P >> 3, c = (P & 7) ^ ((r >> 1) & 7); kdo = r * a.ks + c * 8; }
    }
#define AT_LOAD(t) do { const int t_ = (t); const bool s2_ = t_ >= a.tsplit; const size_t ro_ = (size_t)((s2_ ? t_ - a.tsplit : t_) * 64 + sr) * a.ks + sc; const size_t r32o_ = (size_t)32 * a.ks; \
        if constexpr (F32SRC) { const float* kp_ = (const float*)(s2_ ? a.K2 : a.K1) + ro_; const float* vp_ = (const float*)(s2_ ? a.V2 : a.V1) + ro_; \
            fv0a = *(const f32x4*)vp_; fv0b = *(const f32x4*)(vp_ + 4); fv1a = *(const f32x4*)(vp_ + r32o_); fv1b = *(const f32x4*)(vp_ + r32o_ + 4); \
            fk0a = *(const f32x4*)kp_; fk0b = *(const f32x4*)(kp_ + 4); fk1a = *(const f32x4*)(kp_ + r32o_); fk1b = *(const f32x4*)(kp_ + r32o_ + 4); } \
        else if constexpr (KHALF) { } \
        else { const bf16_t* kp_ = (const bf16_t*)(s2_ ? a.K2 : a.K1) + ro_; const bf16_t* vp_ = (const bf16_t*)(s2_ ? a.V2 : a.V1) + ro_; \
            sv0 = *(const bf16x8*)vp_; sv1 = *(const bf16x8*)(vp_ + r32o_); sk0 = *(const bf16x8*)kp_; sk1 = *(const bf16x8*)(kp_ + r32o_); } \
        if constexpr (MODE == 1) { if (tid < 64) ff = a.F[t_ * 64 + tid]; } } while (0)
#define AT_VDMA(t, bf) do { if constexpr (KHALF) { const int t_ = (t); const bool s2_ = t_ >= a.tsplit; const bf16_t* vb_ = (const bf16_t*)(s2_ ? a.V2 : a.V1) + (size_t)((s2_ ? t_ - a.tsplit : t_) * 64) * a.ks; \
        _Pragma("unroll") for (int j_ = 0; j_ < 2; ++j_) __builtin_amdgcn_global_load_lds((const unsigned*)(vb_ + vdo[j_]), (LAS unsigned*)(V_lds + (bf) * SHM + (wave * 2 + j_) * 1024), 16, 0, 0); \
        const bf16_t* kb_ = (const bf16_t*)(s2_ ? a.K2 : a.K1) + (size_t)((s2_ ? t_ - a.tsplit : t_) * 64) * a.ks + pass * 64; \
        __builtin_amdgcn_global_load_lds((const unsigned*)(kb_ + kdo), (LAS unsigned*)(K_lds + (bf) * SHM + wave * 1024), 16, 0, 0); } } while (0)
#define AT_WRITE(bf) do { const int b_ = (bf); \
        if constexpr (F32SRC) { sk0 = pack8(fk0a, fk0b); sk1 = pack8(fk1a, fk1b); sv0 = pack8(fv0a, fv0b); sv1 = pack8(fv1a, fv1b); } \
        if constexpr (KHALF) { } \
        else { *(LAS bf16x8*)(K_lds + b_ * SHM + kws) = sk0; *(LAS bf16x8*)(K_lds + b_ * SHM + kws + 32 * 256) = sk1; } \
        if constexpr (!KHALF) { *(LAS bf16x8*)(V_lds + b_ * SHM + vst0) = sv0; *(LAS bf16x8*)(V_lds + b_ * SHM + vst1) = sv1; } \
        if constexpr (MODE == 1) { if (tid < 64) fk[b_ * 64 + tid] = -ff; } } while (0)

    for (int pass = 0; pass < NPASS; ++pass) {
        bf16x8 qr[ND0];
#pragma unroll
        for (int d0 = 0; d0 < ND0; ++d0) qr[d0] = wact ? *(const bf16x8*)(a.Q + (size_t)(rg * 32 + r32) * a.qs + (DUAL ? hfw : pass) * 64 + d0 * 16 + hi * 8) : bf16x8{};
        float m_reg = -1e30f, l_reg = 0.f; f32x16 o[4];
#pragma unroll
        for (int d0 = 0; d0 < 4; ++d0) o[d0] = f32x16{};
        float sbound = 0.f; bool wdone = false;
        if constexpr (PRUNE) {
            float qq = 0.f;
#pragma unroll
            for (int d0 = 0; d0 < ND0; ++d0)
#pragma unroll
                for (int e = 0; e < 8; ++e) { const float x = __uint_as_float(((unsigned)(unsigned short)qr[d0][e]) << 16); qq += x * x; }
            { auto rr = __builtin_amdgcn_permlane32_swap(__float_as_uint(qq), __float_as_uint(qq), false, false); qq = __uint_as_float(rr[0]) + __uint_as_float(rr[1]); }
#pragma unroll
            for (int x = 1; x < 32; x <<= 1) qq = fmaxf(qq, __shfl_xor(qq, x));
            sbound = sqrtf(qq * a.kmax2) * 1.02f + 0.5f;
            LAS int* actf = (LAS int*)(lds + L_ACT);
            if (tid < 16) actf[tid] = 0;
        }
#define AT_TILE(i_) (PRUNE ? (a.nt - 1 - (i_)) : (i_))
        AT_LOAD(AT_TILE(0)); AT_VDMA(AT_TILE(0), 0);
        if constexpr (MODE == 0) {
            if (pass == 0 && tid < 256) { int rel = tid - 192; if (rel < -128) rel = -128; float v;
                if (a.tabkind == 0) v = a.tabsrc[t5_bucket(rel) * 8]; else v = a.tabsrc[(rel + 128) * 16];
                tab[tid] = v * LOG2E; }
        }
        AT_WRITE(0);
        __syncthreads();
        if (wave >= 4) __builtin_amdgcn_s_setprio(1);
        for (int it = 0; it < a.nt; ++it) {
            const int buf = it & 1, t = AT_TILE(it);
            if (it + 1 < a.nt) { AT_LOAD(AT_TILE(it + 1)); AT_VDMA(AT_TILE(it + 1), buf ^ 1); }
            SBAR();
            const int kb = a.kpos0 + 64 * t;
            bool act;
            if constexpr (MODE == 0) { const int kc = kb >> 6; act = wact && (kc <= cq) && (kc >= cq - a.band); }
            else act = wact && (kb <= wq0 + 31);
            if constexpr (PRUNE) {
                if (act && !wdone) {
                    float mm = m_reg;
#pragma unroll
                    for (int x = 1; x < 32; x <<= 1) mm = fminf(mm, __shfl_xor(mm, x));
                    const float btile = fk[buf * 64 + 63];
                    if (__all(mm > -1e29f && sbound + btile - mm < -40.0f)) wdone = true;
                }
                act = act && !wdone;
            }
            if (act) {
                f32x16 p0, p1; float alpha = 1.f, ps = 0.f;
                if constexpr (F32SRC) {
                                { const f32x16 z = f32x16{}; qkt<ND0>(p0, p1, z, z, K_lds + buf * SHM + (DUAL ? hfw : pass) * 128, r32, hi, qr); }
                float cb = 0.f;
                if constexpr (MODE == 0) {
                    if (kb - wq0 + 191 <= 0) cb = tab[0];
                    else { const LAS float* tp = tab + (kb - qpos + 4 * hi + 192);
#pragma unroll
                        for (int r = 0; r < 16; ++r) { const int c = (r & 3) + 8 * (r >> 2); p0[r] += tp[c]; p1[r] += tp[c + 32]; } }
                } else {
                    const LAS f32x4* f4 = (const LAS f32x4*)(fk + buf * 64);
#pragma unroll
                    for (int j = 0; j < 4; ++j) { const f32x4 fa = f4[2 * j + hi], fb = f4[8 + 2 * j + hi];
#pragma unroll
                        for (int e = 0; e < 4; ++e) { p0[4 * j + e] += fa[e]; p1[4 * j + e] += fb[e]; } }
                    if (kb + 63 > wq0) { const int dq = qpos - kb - 4 * hi; const float NEG = -__builtin_inff();
#pragma unroll
                        for (int r = 0; r < 16; ++r) { const int c = (r & 3) + 8 * (r >> 2); if (c > dq) p0[r] = NEG; if (c + 32 > dq) p1[r] = NEG; } }
                }
                float pmax = p0[0];
#pragma unroll
                for (int r = 1; r < 16; ++r) pmax = fmaxf(pmax, p0[r]);
#pragma unroll
                for (int r = 0; r < 16; ++r) pmax = fmaxf(pmax, p1[r]);
                { auto rr = __builtin_amdgcn_permlane32_swap(__float_as_uint(pmax), __float_as_uint(pmax), false, false);
                  pmax = fmaxf(__uint_as_float(rr[0]), __uint_as_float(rr[1])) + cb; }
                float mn;
                if (__all((pmax - m_reg) <= THR2)) { mn = m_reg; }
                else { mn = fmaxf(m_reg, pmax); alpha = __builtin_amdgcn_exp2f(m_reg - mn); m_reg = mn; }
                const float mnc = mn - cb;
#pragma unroll
                for (int r = 0; r < 16; ++r) { p0[r] = __builtin_amdgcn_exp2f(p0[r] - mnc); p1[r] = __builtin_amdgcn_exp2f(p1[r] - mnc); ps += p0[r] + p1[r]; }
                { auto rr = __builtin_amdgcn_permlane32_swap(__float_as_uint(ps), __float_as_uint(ps), false, false);
                  ps = __uint_as_float(rr[0]) + __uint_as_float(rr[1]); }
                } else {
                const bool fl = m_reg < -1e29f; const float mref = fl ? 0.f : m_reg;
#define AT_BIAS(D0, D1, OP) do { \
                if constexpr (MODE == 0) { \
                    if (kb - wq0 + 191 <= 0) { const float nb = tab[0] - mref; \
                        _Pragma("unroll") for (int r = 0; r < 16; ++r) { D0[r] OP nb; D1[r] OP nb; } } \
                    else { const LAS float* tp = tab + (kb - qpos + 4 * hi + 192); \
                        _Pragma("unroll") for (int r = 0; r < 16; ++r) { const int c = (r & 3) + 8 * (r >> 2); D0[r] OP tp[c] - mref; D1[r] OP tp[c + 32] - mref; } } \
                } else { \
                    const LAS f32x4* f4 = (const LAS f32x4*)(fk + buf * 64); \
                    _Pragma("unroll") for (int j = 0; j < 4; ++j) { const f32x4 fa = f4[2 * j + hi], fb = f4[8 + 2 * j + hi]; \
                        _Pragma("unroll") for (int e = 0; e < 4; ++e) { D0[4 * j + e] OP fa[e] - mref; D1[4 * j + e] OP fb[e] - mref; } } \
                } } while (0)
                if (MODE == 0 && kb - wq0 + 191 <= 0) {
                    f32x16 c; const float nb = tab[0] - mref;
#pragma unroll
                    for (int r = 0; r < 16; ++r) c[r] = nb;
                    qkt<ND0, KHALF>(p0, p1, c, c, K_lds + buf * SHM + (KHALF ? 0 : (DUAL ? hfw : pass) * 128), r32, hi, qr);
                } else { f32x16 c0, c1; AT_BIAS(c0, c1, =); qkt<ND0, KHALF>(p0, p1, c0, c1, K_lds + buf * SHM + (KHALF ? 0 : (DUAL ? hfw : pass) * 128), r32, hi, qr); }
#undef AT_BIAS
                if constexpr (MODE == 1) {
                    if (kb + 63 > wq0) { const int dq = qpos - kb - 4 * hi; const float NEG = -__builtin_inff();
#pragma unroll
                        for (int r = 0; r < 16; ++r) { const int c = (r & 3) + 8 * (r >> 2); if (c > dq) p0[r] = NEG; if (c + 32 > dq) p1[r] = NEG; } }
                }
                float pmax = p0[0];
#pragma unroll
                for (int r = 1; r < 16; ++r) pmax = fmaxf(pmax, p0[r]);
#pragma unroll
                for (int r = 0; r < 16; ++r) pmax = fmaxf(pmax, p1[r]);
                { auto rr = __builtin_amdgcn_permlane32_swap(__float_as_uint(pmax), __float_as_uint(pmax), false, false);
                  pmax = fmaxf(__uint_as_float(rr[0]), __uint_as_float(rr[1])); }
                float d = 0.f;
                const bool common = __all(!fl && pmax <= THR2);
                if (!common) { d = fl ? fmaxf(pmax, -1e30f) : fmaxf(pmax, 0.f); alpha = fl ? 1.f : __builtin_amdgcn_exp2f(-d); m_reg = mref + d; }
                if (common) {
#pragma unroll
                    for (int r = 0; r < 16; ++r) { p0[r] = __builtin_amdgcn_exp2f(p0[r]); p1[r] = __builtin_amdgcn_exp2f(p1[r]); ps += p0[r] + p1[r]; }
                } else {
#pragma unroll
                    for (int r = 0; r < 16; ++r) { p0[r] = __builtin_amdgcn_exp2f(p0[r] - d); p1[r] = __builtin_amdgcn_exp2f(p1[r] - d); ps += p0[r] + p1[r]; }
                }
                { auto rr = __builtin_amdgcn_permlane32_swap(__float_as_uint(ps), __float_as_uint(ps), false, false);
                  ps = __uint_as_float(rr[0]) + __uint_as_float(rr[1]); }
                }
                l_reg = l_reg * alpha + ps;
                bf16x8 pa0, pa1, pa2, pa3;
#define PK4(P, B_, OUT) do { unsigned a0 = cvtpk(P[B_+0], P[B_+1]), a1 = cvtpk(P[B_+2], P[B_+3]); \
        unsigned b0 = cvtpk(P[B_+4], P[B_+5]), b1 = cvtpk(P[B_+6], P[B_+7]); \
        auto r0 = __builtin_amdgcn_permlane32_swap(a0, b0, false, false); auto r1 = __builtin_amdgcn_permlane32_swap(a1, b1, false, false); \
        u32x4 w = {r0[0], r1[0], r0[1], r1[1]}; OUT = *reinterpret_cast<bf16x8*>(&w); } while (0)
                PK4(p0, 0, pa0); PK4(p0, 8, pa1); PK4(p1, 0, pa2); PK4(p1, 8, pa3);
#undef PK4
                if (__any(alpha < 1.f)) {
#pragma unroll
                    for (int d0 = 0; d0 < 4; ++d0)
#pragma unroll
                        for (int r = 0; r < 16; ++r) o[d0][r] *= alpha; }
                pv_tile(o, vb + buf * SHM, pa0, pa1, pa2, pa3);
            }
            SBAR();
            if (it + 1 < a.nt) AT_WRITE(buf ^ 1);
            if constexpr (PRUNE) { if (lane == 0) ((LAS int*)(lds + L_ACT))[buf * 8 + wave] = (wact && !wdone) ? 1 : 0; }
            __syncthreads();
            if constexpr (PRUNE) { const LAS int* af = (const LAS int*)(lds + L_ACT) + buf * 8; int any = 0;
#pragma unroll
                for (int w = 0; w < 8; ++w) any |= af[w];
                if (!any) break; }
        }
#undef AT_TILE
        __builtin_amdgcn_s_setprio(0);
        const float rl = __builtin_amdgcn_rcpf(l_reg);
#define AT_STORE_ROW(OROW, VAL) do { _Pragma("unroll") for (int d0 = 0; d0 < 4; ++d0) _Pragma("unroll") for (int k = 0; k < 2; ++k) { \
            unsigned x0 = cvtpk(VAL(d0, 8 * k + 0), VAL(d0, 8 * k + 1)), x1 = cvtpk(VAL(d0, 8 * k + 2), VAL(d0, 8 * k + 3)); \
            unsigned y0 = cvtpk(VAL(d0, 8 * k + 4), VAL(d0, 8 * k + 5)), y1 = cvtpk(VAL(d0, 8 * k + 6), VAL(d0, 8 * k + 7)); \
            auto s0 = __builtin_amdgcn_permlane32_swap(x0, y0, false, false); auto s1 = __builtin_amdgcn_permlane32_swap(x1, y1, false, false); \
            u32x4 w = {s0[0], s1[0], s0[1], s1[1]}; \
            int oo = d0 * 32 + 16 * k + 8 * hi; asm volatile("" : "+v"(oo)); \
            *(u32x4*)((OROW) + oo) = w; } } while (0)
        if constexpr (DUAL) {
            LAS float* X = (LAS float*)(lds + 73728);
            if (wact && hfw == 1) {
#pragma unroll
                for (int r = 0; r < 16; ++r)
#pragma unroll
                    for (int d0 = 0; d0 < 4; ++d0) X[(rg * 64 + r * 4 + d0) * 64 + lane] = o[d0][r] * rl;
            }
            __syncthreads();
            if (wact && hfw == 0) {
                float ssq = 0.f;
#pragma unroll
                for (int r = 0; r < 16; ++r)
#pragma unroll
                    for (int d0 = 0; d0 < 4; ++d0) { const float v = o[d0][r] * rl - a.lam * X[(rg * 64 + r * 4 + d0) * 64 + lane]; o[d0][r] = v; ssq += v * v; }
                { auto rr = __builtin_amdgcn_permlane32_swap(__float_as_uint(ssq), __float_as_uint(ssq), false, false); ssq = __uint_as_float(rr[0]) + __uint_as_float(rr[1]); }
                const float rs = 0.8f * __builtin_amdgcn_rsqf(ssq * (1.0f / 128.0f) + EPS);
                bf16_t* orow = a.O + (size_t)(rg * 32 + r32) * a.os;
                const float* gp = a.subg + 4 * hi;
#pragma unroll
                for (int d0 = 0; d0 < 4; ++d0)
#pragma unroll
                    for (int g = 0; g < 4; ++g) { const f32x4 gg = *(const f32x4*)(gp + d0 * 32 + 8 * g);
#pragma unroll
                        for (int e = 0; e < 4; ++e) o[d0][4 * g + e] *= rs * gg[e]; }
#define AT_VAL(d0_, r_) o[d0_][r_]
                AT_STORE_ROW(orow, AT_VAL);
#undef AT_VAL
            }
        } else
        if (wact) {
            if (DQK == 64 && pass == 0) {
#pragma unroll
                for (int r = 0; r < 16; ++r) {
                    int so = wave * 4096 + r * 256 + lane; asm volatile("" : "+v"(so));
                    float* sp = a.o1s + so;
#pragma unroll
                    for (int d0 = 0; d0 < 4; ++d0) sp[d0 * 64] = o[d0][r] * rl; }
                VM_WAIT();
            } else {
                bf16_t* orow = a.O + (size_t)(wave * 32 + r32) * a.os;
                if constexpr (DQK == 64) {
                    float ssq = 0.f;
#pragma unroll
                    for (int r = 0; r < 16; ++r) {
                        int so = wave * 4096 + r * 256 + lane; asm volatile("" : "+v"(so));
                        const float* sp = a.o1s + so;
#pragma unroll
                        for (int d0 = 0; d0 < 4; ++d0) { const float o1 = __hip_atomic_load(sp + d0 * 64, __ATOMIC_RELAXED, __HIP_MEMORY_SCOPE_AGENT);
                            const float v = o1 - a.lam * (o[d0][r] * rl); o[d0][r] = v; ssq += v * v; } }
                    { auto rr = __builtin_amdgcn_permlane32_swap(__float_as_uint(ssq), __float_as_uint(ssq), false, false); ssq = __uint_as_float(rr[0]) + __uint_as_float(rr[1]); }
                    const float rs = 0.8f * __builtin_amdgcn_rsqf(ssq * (1.0f / 128.0f) + EPS);
                    const float* gp = a.subg + 4 * hi;
#pragma unroll
                    for (int d0 = 0; d0 < 4; ++d0)
#pragma unroll
                        for (int g = 0; g < 4; ++g) { const f32x4 gg = *(const f32x4*)(gp + d0 * 32 + 8 * g);
#pragma unroll
                            for (int e = 0; e < 4; ++e) o[d0][4 * g + e] *= rs * gg[e]; }
                } else {
#pragma unroll
                    for (int d0 = 0; d0 < 4; ++d0)
#pragma unroll
                        for (int r = 0; r < 16; ++r) o[d0][r] *= rl;
                }
#define AT_VAL(d0_, r_) o[d0_][r_]
                AT_STORE_ROW(orow, AT_VAL);
#undef AT_VAL
            }
        }
#undef AT_STORE_ROW
        __syncthreads();
    }
#undef AT_LOAD
#undef AT_WRITE
#undef AT_VDMA
}
}

struct KArgs { InPtrs in; float* out; unsigned char* ws; int ph_lo, ph_hi; };

#define Q_PRE() unsigned nx_ = 0u; if (tid == 0) nx_ = __hip_atomic_fetch_add(qw, 1u, __ATOMIC_RELAXED, __HIP_MEMORY_SCOPE_AGENT)
__device__ __forceinline__ int q_post(unsigned nx, volatile LAS unsigned* slot, int tid) {
    if (tid == 0) *slot = nx;
    __syncthreads();
    return (int)*slot;
}
__device__ __forceinline__ int q_next(unsigned* qw, volatile LAS unsigned* slot, int tid) {
    __syncthreads();
    if (tid == 0) *slot = __hip_atomic_fetch_add(qw, 1u, __ATOMIC_RELAXED, __HIP_MEMORY_SCOPE_AGENT);
    __syncthreads();
    return (int)*slot;
}

__device__ __forceinline__ void sample_qkv_finalize(const float* part, int b, int colq, int colk, int colv, float qscale, bf16_t* BIG, float* outK, float* outV, int ldf, int hcol, int tid) {
    for (int i = tid; i < 3 * 64 * 16; i += 512) {
        const int sec3 = i >> 10, r = (i & 1023) >> 4, c8 = (i & 15) * 8;
        const int col = (sec3 == 0 ? colq : (sec3 == 1 ? colk : colv)) + c8;
        const float* pp = part + ((size_t)(b * 64 + r)) * NQKV + col;
        f32x4 s0 = {0.f, 0.f, 0.f, 0.f}, s1 = {0.f, 0.f, 0.f, 0.f};
#pragma unroll
        for (int sl = 0; sl < 5; ++sl) { s0 += *(const f32x4*)(pp + (size_t)sl * MS * NQKV); s1 += *(const f32x4*)(pp + (size_t)sl * MS * NQKV + 4); }
        if (sec3 == 1) { float* d = outK + (size_t)(b * 64 + r) * ldf + hcol + c8; *(f32x4*)d = s0; *(f32x4*)(d + 4) = s1; }
        if (sec3 == 2) { float* d = outV + (size_t)(b * 64 + r) * ldf + hcol + c8; *(f32x4*)d = s0; *(f32x4*)(d + 4) = s1; }
        const float sc = sec3 == 0 ? qscale : 1.0f;
        u32x4 w; w.x = cvtpk(s0[0] * sc, s0[1] * sc); w.y = cvtpk(s0[2] * sc, s0[3] * sc); w.z = cvtpk(s1[0] * sc, s1[1] * sc); w.w = cvtpk(s1[2] * sc, s1[3] * sc);
        *(u32x4*)(BIG + (size_t)(MP + b * 64 + r) * NQKV + col) = w;
    }
    VM_WAIT(); __syncthreads();
}

template <int l>
__device__ __forceinline__ void layer_phases(LAS unsigned char* lds, unsigned char* ws, float* out, unsigned* ctl, const XcdBarrier& bar, int G, int wg, int wave0, int lo, int hi_, int& phase) {
    volatile LAS unsigned* MISC = (volatile LAS unsigned*)(lds + MISC_OFF);
    bf16_t* H = (bf16_t*)(ws + WS_H); bf16_t* BIG = (bf16_t*)(ws + WS_BIG); bf16_t* ATT = (bf16_t*)(ws + WS_ATT); bf16_t* XB = (bf16_t*)(ws + WS_XB);
    float* mods = (float*)(ws + WS_MODS);
#define PH_BEGIN if (phase >= lo && phase < hi_) { const int tid = fresh_tid(wave0), lane = tid & 63, wave = __builtin_amdgcn_readfirstlane(tid >> 6); (void)lane; (void)wave;
#define PH_END   if (MK_N_LAUNCHES == 1) xcd_barrier(bar, fresh_tid(wave0)); } ++phase;
#define MODS_L (mods + (size_t)l * 16 * NADA)
#define NG_L (inp(lds, 13) + (size_t)l * 3 * DM)
        PH_BEGIN { if (EN(2)) { norm_phase<false>((l == 0) ? inp(lds, 0) : nullptr, (l == 0) ? inp(lds, 1) : nullptr, XB, NG_L, MODS_L, 0, H, nullptr, nullptr, out, SampleFix{(const float*)(ws + WS_PART), (l == 0) ? 0 : 15, mods + 8 * DM, 0.5f}, lds, G, wg, tid, wave, lane); } } PH_END
        PH_BEGIN { pg8::Gemm g{H, (const bf16_t*)(ws + WS_WFI + (size_t)(l * 2 + 0) * SZ_WFI), MROWS, 11008, DM}; pg8::StaticOrder S; S.init(MROWS, 11008, G, wg); S.ntk = DM / 64;
            EpiSwiGLU E{BIG}; { if (EN(6)) { pg8::gemm_phase<EpiSwiGLU, pg8::StaticOrder, true, true>(lds, g, S, E, wave0); } } } PH_END
        PH_BEGIN { pg8::Gemm g{BIG, (const bf16_t*)(ws + WS_WFO + (size_t)(l * 2 + 0) * SZ_WFO), MROWS, DM, DFF}; pg8::SplitOrder S; S.init(DFF, DM, 15, G, wg);
            EpiResGate E{(l == 0) ? inp(lds, 0) : nullptr, XB, MODS_L + 2 * DM, 0.5f, (float*)(ws + WS_PART)}; { if (EN(7)) { pg8::gemm_phase<EpiResGate, pg8::SplitOrder, true, true>(lds, g, S, E, wave0); } } } PH_END
        PH_BEGIN if (l == 0) { if (EN(3)) { norm_phase<true>(nullptr, inp(lds, 1), XB, NG_L + DM, MODS_L, 3, H, inp(lds, 16), inp(lds, 17), out, SampleFix{(const float*)(ws + WS_PART), 15, MODS_L + 2 * DM, 0.5f}, lds, G, wg, tid, wave, lane); } }
                 else { if (EN(2)) { norm_phase<false>(nullptr, nullptr, XB, NG_L + DM, MODS_L, 3, H, nullptr, nullptr, out, SampleFix{(const float*)(ws + WS_PART), 15, MODS_L + 2 * DM, 0.5f}, lds, G, wg, tid, wave, lane); } } PH_END
        PH_BEGIN {
            if (l == 0 && wg < 128) {
                const int s = wg & 63, b = s >> 3, hh = s & 7;
                const bool smp = wg >= 64;
                const float* s1 = smp ? inp(lds, 6) + (size_t)b * PAST * 8 + hh : out + OFF_BFP + (size_t)b * SEQ * 8 + hh;
                const float* s2 = out + OFF_BFS + (size_t)b * DSEQ * 8 + hh;
                float* dst = smp ? (float*)(ws + WS_FS) + (size_t)s * (PAST + DSEQ) : (float*)(ws + WS_FP) + (size_t)s * SEQ;
                { if (EN(5)) { cumsum_seq(s1, SEQ, s2, smp ? DSEQ : 0, dst, lds, tid, wave, lane); } }
            }
            pg8::Gemm g{H, (const bf16_t*)(ws + (l == 0 ? WS_WINAB : WS_WINC)), MROWS, NQKV, DM}; pg8::SplitOrder S; S.init(DM, NQKV, 5, G, wg);
            EpiQKV E{BIG, out, l, (float*)(ws + WS_PART)};
            { if (EN(8)) { pg8::gemm_phase<EpiQKV, pg8::SplitOrder, true, true>(lds, g, S, E, wave0); } } } PH_END
        PH_BEGIN {
            att::Args a; a.o1s = (float*)(ws + WS_O1) + (size_t)wg * 32768; a.subg = inp(lds, 23); a.lam = 0.f; a.kmax2 = 0.f; a.F = nullptr; a.tabsrc = nullptr; a.tabkind = 0; a.band = 1 << 20;
            if (l == 0) {
                { float v1 = (lane < 64) ? inp(lds, 19)[lane] * inp(lds, 20)[lane] : 0.f, v2 = inp(lds, 21)[lane] * inp(lds, 22)[lane];
                  a.lam = expf(wave_sum(v1)) - expf(wave_sum(v2)) + 0.2f; }
                for (int u = wg; u < 256; u += G) {
                    const int s = u >> 2, b = s >> 3, h = s & 7;
                    const bf16_t* kp = BIG + (size_t)(b * SEQ + (u & 3) * 1024 + (tid >> 4)) * NQKV + 4096 + h * 128 + (tid & 15) * 8;
                    float mx = 0.f;
#pragma unroll 4
                    for (int i = 0; i < 32; ++i) { const bf16x8 v = *(const bf16x8*)(kp + (size_t)(32 * i) * NQKV); float ss = 0.f;
#pragma unroll
                        for (int e = 0; e < 8; ++e) { const float x = __uint_as_float(((unsigned)(unsigned short)v[e]) << 16); ss += x * x; }
                        ss += __shfl_xor(ss, 1); ss += __shfl_xor(ss, 2); ss += __shfl_xor(ss, 4); ss += __shfl_xor(ss, 8);
                        mx = fmaxf(mx, ss); }
                    mx = fmaxf(mx, __shfl_xor(mx, 16)); mx = fmaxf(mx, __shfl_xor(mx, 32));
                    if (lane == 0) __hip_atomic_fetch_max(ctl + CW_KMX + s, __float_as_uint(mx), __ATOMIC_RELAXED, __HIP_MEMORY_SCOPE_AGENT);
                }
                VM_WAIT(); __syncthreads();
                if (tid == 0) __hip_atomic_fetch_add(ctl + CW_KDONE, 1u, __ATOMIC_RELAXED, __HIP_MEMORY_SCOPE_AGENT);
                unsigned* qw = ctl + CW_Q0;
                int idx = q_next(qw, MISC + 12, tid);
                while (idx < 64) { Q_PRE(); const int b = idx >> 3, h = idx & 7;
                    a.K1 = inp(lds, 2) + ((size_t)b * PAST * 8 + h) * 128; a.V1 = inp(lds, 3) + ((size_t)b * PAST * 8 + h) * 128;
                    a.K2 = out + OFF_AKS + ((size_t)b * DSEQ * 8 + h) * 128; a.V2 = out + OFF_AVS + ((size_t)b * DSEQ * 8 + h) * 128; a.ks = 1024;
                    a.Q = BIG + (size_t)(MP + b * DSEQ) * NQKV + h * 128; a.qs = NQKV; a.O = ATT + (size_t)(MP + b * DSEQ) * DM + h * 128; a.os = DM;
                    a.nrows = 64; a.qpos0 = PAST; a.kpos0 = 0; a.nt = 65; a.tsplit = 64; a.tabsrc = inp(lds, 24) + h; a.tabkind = 0;
                    sample_qkv_finalize((const float*)(ws + WS_PART), b, h * 128, 1024 + h * 128, 2048 + h * 128, 1.0f, BIG, out + OFF_AKS, out + OFF_AVS, 1024, h * 128, tid);
                    { if (EN(9)) { att::attn_item<true, 64, 0>(lds, a, wave0); } } idx = q_post(nx_, MISC + 12 + (idx & 1), tid); }
                while (idx < 128) { Q_PRE(); const int s = idx - 64, b = s >> 3, h = s & 7;
                    a.K1 = inp(lds, 4) + ((size_t)b * PAST * 8 + h) * 128; a.V1 = inp(lds, 5) + ((size_t)b * PAST * 8 + h) * 128;
                    a.K2 = out + OFF_BKS + ((size_t)b * DSEQ * 8 + h) * 128; a.V2 = out + OFF_BVS + ((size_t)b * DSEQ * 8 + h) * 128; a.ks = 1024;
                    a.Q = BIG + (size_t)(MP + b * DSEQ) * NQKV + 3072 + h * 128; a.qs = NQKV; a.O = ATT + (size_t)(MP + b * DSEQ) * DM + 1024 + h * 128; a.os = DM;
                    a.nrows = 64; a.qpos0 = PAST; a.kpos0 = 0; a.nt = 65; a.tsplit = 64; a.F = (const float*)(ws + WS_FS) + (size_t)s * (PAST + DSEQ);
                    sample_qkv_finalize((const float*)(ws + WS_PART), b, 3072 + h * 128, 4096 + h * 128, 5120 + h * 128, 1.0f, BIG, out + OFF_BKS, out + OFF_BVS, 1024, h * 128, tid);
                    { if (EN(10)) { att::attn_item<true, 128, 1>(lds, a, wave0); } } idx = q_post(nx_, MISC + 12 + (idx & 1), tid); }
                while (idx < 128 + 1024) { Q_PRE(); const int p = idx - 128, j = 15 - (p >> 6), s = p & 63, b = s >> 3, h = s & 7;
                    const bf16_t* base = BIG + (size_t)(b * SEQ) * NQKV + h * 128;
                    a.K1 = base + 1024; a.V1 = base + 2048; a.K2 = a.K1; a.V2 = a.V1; a.ks = NQKV;
                    a.Q = base + (size_t)(256 * j) * NQKV; a.qs = NQKV; a.O = ATT + (size_t)(b * SEQ + 256 * j) * DM + h * 128; a.os = DM;
                    a.nrows = 256; a.qpos0 = 256 * j; a.kpos0 = 0; a.nt = 4 * (j + 1); a.tsplit = 1 << 20; a.tabsrc = inp(lds, 24) + h; a.tabkind = 0;
                    { if (EN(11)) { att::attn_item<false, 64, 0>(lds, a, wave0); } } idx = q_post(nx_, MISC + 12 + (idx & 1), tid); }
                if (idx < 128 + 2048) {
                    if (tid == 0) { unsigned sp = 0; while (__hip_atomic_load(ctl + CW_KDONE, __ATOMIC_RELAXED, __HIP_MEMORY_SCOPE_AGENT) < (unsigned)G) { __builtin_amdgcn_s_sleep(2); if (++sp > (1u << 22)) break; } }
                    __syncthreads();
                }
                while (idx < 128 + 2048) { Q_PRE(); const int p = idx - 128 - 1024, j = 15 - (p >> 6), s = p & 63, b = s >> 3, h = s & 7;
                    const bf16_t* base = BIG + (size_t)(b * SEQ) * NQKV + h * 128;
                    a.K1 = base + 4096; a.V1 = base + 5120; a.K2 = a.K1; a.V2 = a.V1; a.ks = NQKV;
                    a.Q = base + 3072 + (size_t)(256 * j) * NQKV; a.qs = NQKV; a.O = ATT + (size_t)(b * SEQ + 256 * j) * DM + 1024 + h * 128; a.os = DM;
                    a.nrows = 256; a.qpos0 = 256 * j; a.kpos0 = 0; a.nt = 4 * (j + 1); a.tsplit = 1 << 20; a.F = (const float*)(ws + WS_FP) + (size_t)s * SEQ;
                    a.kmax2 = __uint_as_float(__hip_atomic_load(ctl + CW_KMX + s, __ATOMIC_RELAXED, __HIP_MEMORY_SCOPE_AGENT));
                    { if (EN(12)) { att::attn_item<false, 128, 1, true>(lds, a, wave0); } } idx = q_post(nx_, MISC + 12 + (idx & 1), tid); }
            } else {
                unsigned* qw = ctl + CW_Q1;
                int idx = q_next(qw, MISC + 12, tid);
                a.band = 8; a.tabkind = 1;
                while (idx < 128) { Q_PRE(); const int b = idx >> 4, h = idx & 15;
                    a.K1 = inp(lds, 7) + ((size_t)b * 512 * 16 + h) * 128; a.V1 = inp(lds, 8) + ((size_t)b * 512 * 16 + h) * 128;
                    a.K2 = out + OFF_CKS + ((size_t)b * DSEQ * 16 + h) * 128; a.V2 = out + OFF_CVS + ((size_t)b * DSEQ * 16 + h) * 128; a.ks = 2048;
                    a.Q = BIG + (size_t)(MP + b * DSEQ) * NQKV + h * 128; a.qs = NQKV; a.O = ATT + (size_t)(MP + b * DSEQ) * DM + h * 128; a.os = DM;
                    a.nrows = 64; a.qpos0 = PAST; a.kpos0 = PAST - 512; a.nt = 9; a.tsplit = 8; a.tabsrc = inp(lds, 27) + h;
                    sample_qkv_finalize((const float*)(ws + WS_PART), b, h * 128, 2048 + h * 128, 4096 + h * 128, 1.0f, BIG, out + OFF_CKS, out + OFF_CVS, 2048, h * 128, tid);
                    { if (EN(13)) { att::attn_item<true, 128, 0>(lds, a, wave0); } } idx = q_post(nx_, MISC + 12 + (idx & 1), tid); }
                while (idx < 128 + 2048) { Q_PRE(); const int p = idx - 128, j = 15 - (p >> 7), s = p & 127, b = s >> 4, h = s & 15;
                    const int c0 = (4 * j - 8) > 0 ? (4 * j - 8) : 0;
                    const bf16_t* base = BIG + (size_t)(b * SEQ) * NQKV + h * 128;
                    a.K1 = base + 2048 + (size_t)(64 * c0) * NQKV; a.V1 = base + 4096 + (size_t)(64 * c0) * NQKV; a.K2 = a.K1; a.V2 = a.V1; a.ks = NQKV;
                    a.Q = base + (size_t)(256 * j) * NQKV; a.qs = NQKV; a.O = ATT + (size_t)(b * SEQ + 256 * j) * DM + h * 128; a.os = DM;
                    a.nrows = 256; a.qpos0 = 256 * j; a.kpos0 = 64 * c0; a.nt = 4 * j + 4 - c0; a.tsplit = 1 << 20; a.tabsrc = inp(lds, 27) + h;
                    { if (EN(14)) { att::attn_item<false, 128, 0>(lds, a, wave0); } } idx = q_post(nx_, MISC + 12 + (idx & 1), tid); }
            }
        } PH_END
        PH_BEGIN { pg8::Gemm g{ATT, (const bf16_t*)(ws + (l == 0 ? WS_WOUTAB : WS_WOUTC)), MROWS, DM, DM}; pg8::SplitOrder S; S.init(DM, DM, 8, G, wg);
            EpiResGate E{nullptr, XB, MODS_L + 5 * DM, 1.0f, (float*)(ws + WS_PART)}; { if (EN(7)) { pg8::gemm_phase<EpiResGate, pg8::SplitOrder, true, true>(lds, g, S, E, wave0); } } } PH_END
        PH_BEGIN { if (EN(2)) { norm_phase<false>(nullptr, nullptr, XB, NG_L + 2 * DM, MODS_L, 6, H, nullptr, nullptr, out, SampleFix{(const float*)(ws + WS_PART), 8, MODS_L + 5 * DM, 1.0f}, lds, G, wg, tid, wave, lane); } } PH_END
        PH_BEGIN { pg8::Gemm g{H, (const bf16_t*)(ws + WS_WFI + (size_t)(l * 2 + 1) * SZ_WFI), MROWS, 11008, DM}; pg8::StaticOrder S; S.init(MROWS, 11008, G, wg); S.ntk = DM / 64;
            EpiSwiGLU E{BIG}; { if (EN(6)) { pg8::gemm_phase<EpiSwiGLU, pg8::StaticOrder, true, true>(lds, g, S, E, wave0); } } } PH_END
        PH_BEGIN { pg8::Gemm g{BIG, (const bf16_t*)(ws + WS_WFO + (size_t)(l * 2 + 1) * SZ_WFO), MROWS, DM, DFF}; pg8::SplitOrder S; S.init(DFF, DM, 15, G, wg);
            EpiResGate E{nullptr, XB, MODS_L + 8 * DM, 0.5f, (float*)(ws + WS_PART)}; { if (EN(7)) { pg8::gemm_phase<EpiResGate, pg8::SplitOrder, true, true>(lds, g, S, E, wave0); } } } PH_END
#undef PH_BEGIN
#undef PH_END
}

__global__ void __launch_bounds__(512, 2) mega_fwd(KArgs args) {
    extern __shared__ __attribute__((aligned(16))) unsigned char lds_raw[];
    LAS unsigned char* lds = (LAS unsigned char*)lds_raw;
    volatile LAS unsigned* MISC = (volatile LAS unsigned*)(lds + MISC_OFF);
    const int tid0 = threadIdx.x;
    const int wave0 = __builtin_amdgcn_readfirstlane(tid0 >> 6);
    const int G = gridDim.x, wg = blockIdx.x;
    unsigned char* ws = args.ws; float* out = args.out;
    unsigned* ctl = (unsigned*)(ws + WS_CTL);
    for (int u = tid0; u < (LDS_BYTES - LDSCTL_OFF) / 4; u += 512) ((LAS unsigned*)(lds + LDSCTL_OFF))[u] = 0u;
    __syncthreads();
    if (tid0 == 0) {
#pragma unroll
        for (int i = 0; i < 29; ++i) ((LAS unsigned long long*)(lds + PTAB_OFF))[i] = (unsigned long long)args.in.p[i];
    }
    __syncthreads();
    XcdBarrier bar; bar.bar = ctl + CW_BAR; bar.x = 0; bar.st = nullptr;
    if (MK_N_LAUNCHES == 1) bar = xcd_barrier_post(ctl + CW_BAR, MISC + 8, tid0);
    const int lo = args.ph_lo, hi_ = args.ph_hi;
    int phase = 0;
#define PH_BEGIN if (phase >= lo && phase < hi_) { const int tid = fresh_tid(wave0), lane = tid & 63, wave = __builtin_amdgcn_readfirstlane(tid >> 6); (void)lane; (void)wave;
#define PH_END   if (MK_N_LAUNCHES == 1) xcd_barrier(bar, fresh_tid(wave0)); } ++phase;

    bf16_t* H = (bf16_t*)(ws + WS_H); bf16_t* BIG = (bf16_t*)(ws + WS_BIG); bf16_t* ATT = (bf16_t*)(ws + WS_ATT);
    float* mods = (float*)(ws + WS_MODS);

    PH_BEGIN { if (EN(0)) { prologue_phase(ws, lds, G, wg, tid, wave, lane); } } PH_END
    PH_BEGIN { if (EN(1)) { mods_finalize(lds, ws, G, wg, tid); } } PH_END

    layer_phases<0>(lds, ws, out, ctl, bar, G, wg, wave0, lo, hi_, phase);
    layer_phases<1>(lds, ws, out, ctl, bar, G, wg, wave0, lo, hi_, phase);
    PH_BEGIN { if (EN(4)) { final_norm_phase((bf16_t*)(ws + WS_XB), out, inp(lds, 28), SampleFix{(const float*)(ws + WS_PART), 15, (const float*)(ws + WS_MODS) + (size_t)16 * NADA + 8 * DM, 0.5f}, G, wg, wave, lane); } } }
#undef PH_BEGIN
#undef PH_END
}
constexpr int N_PHASES = 64;

extern "C" void kernel_launch(void* const* d_in, const int* in_sizes, int n_in, void* d_out, int out_size, void* d_ws, size_t ws_size, hipStream_t stream) {
    static int grid = 0;
    if (grid == 0) {
        if (n_in != 29 || (size_t)out_size != OUT_TOTAL || ws_size < WS_END) { fprintf(stderr, "kernel_launch: unexpected shapes (n_in %d, out %d, ws %zu; need ws >= %zu)\n", n_in, out_size, ws_size, (size_t)WS_END); grid = -1; return; }
        int dev = 0, cus = 0;
        if (hipGetDevice(&dev) != hipSuccess || hipDeviceGetAttribute(&cus, hipDeviceAttributeMultiprocessorCount, dev) != hipSuccess) { grid = -1; return; }
        if (hipFuncSetAttribute((const void*)mega_fwd, hipFuncAttributeMaxDynamicSharedMemorySize, LDS_BYTES) != hipSuccess) { fprintf(stderr, "kernel_launch: hipFuncSetAttribute failed\n"); grid = -1; return; }
        int per_cu = 0;
        if (hipOccupancyMaxActiveBlocksPerMultiprocessor(&per_cu, (const void*)mega_fwd, 512, LDS_BYTES) != hipSuccess || per_cu < 1) { fprintf(stderr, "kernel_launch: occupancy query says %d blocks per CU\n", per_cu); }
        (void)hipGetLastError();
        grid = cus;
    }
    if (grid < 0) return;
    (void)hipMemsetAsync((char*)d_ws + WS_CTL, 0, 128 * 1024, stream);
    KArgs a{};
    for (int i = 0; i < 29; ++i) a.in.p[i] = (const float*)d_in[i];
    a.out = (float*)d_out; a.ws = (unsigned char*)d_ws;
    if (MK_N_LAUNCHES == 1) { a.ph_lo = 0; a.ph_hi = N_PHASES; hipLaunchKernelGGL(mega_fwd, dim3(grid), dim3(512), LDS_BYTES, stream, a); }
    else { for (int p = 0; p < N_PHASES; ++p) { a.ph_lo = p; a.ph_hi = p + 1; hipLaunchKernelGGL(mega_fwd, dim3(grid), dim3(512), LDS_BYTES, stream, a); } }
}
```

```cpp
#include <hip/hip_runtime.h>
#include <cstdio>
#include <cstdint>

#ifndef MK_N_LAUNCHES
#define MK_N_LAUNCHES 1
#endif

#ifndef DIS
#define DIS 0
#endif
#define EN(bit) (!(((DIS) >> (bit)) & 1))
#define LAS __attribute__((address_space(3)))
typedef unsigned short bf16_t;
typedef short bf16x8 __attribute__((ext_vector_type(8)));
typedef short s16x4 __attribute__((ext_vector_type(4)));
typedef float f32x4 __attribute__((ext_vector_type(4)));
typedef float f32x16 __attribute__((ext_vector_type(16)));
typedef unsigned u32x4 __attribute__((ext_vector_type(4)));
typedef unsigned u32x2 __attribute__((ext_vector_type(2)));

constexpr int DM = 2048, NBATCH = 8, SEQ = 4096, DSEQ = 64, PAST = 4096, DFF = 5504, NADA = 9 * DM;
constexpr int MP = NBATCH * SEQ, MS = NBATCH * DSEQ, MROWS = MP + MS;
constexpr int NQKV = 6144, LD_WINAB = 6152;
constexpr float LOG2E = 1.4426950408889634f;
constexpr float QSCALE_A = 0.125f * LOG2E;
constexpr float QSCALE_B = 0.08838834764831845f * LOG2E;
constexpr float EPS = 1e-6f;

constexpr size_t OFF_Y = 0;
constexpr size_t OFF_AKP = 68157440, OFF_AVP = 101711872, OFF_BKP = 135266304, OFF_BVP = 168820736, OFF_BFP = 202375168;
constexpr size_t OFF_CKP = 202637312, OFF_CVP = 211025920;
constexpr size_t OFF_AKS = 219414528, OFF_AVS = 219938816, OFF_BKS = 220463104, OFF_BVS = 220987392, OFF_BFS = 221511680;
constexpr size_t OFF_CKS = 221515776, OFF_CVS = 222564352, OUT_TOTAL = 223612928;

constexpr size_t MiB = 1u << 20;
constexpr size_t WS_CTL = 0, CTL_BYTES = 1 * MiB;
constexpr size_t SZ_WFI = (size_t)11008 * 2048 * 2, SZ_WFO = (size_t)2048 * 5504 * 2;
constexpr size_t WS_WFI = 1 * MiB;
constexpr size_t WS_WFO = WS_WFI + 4 * SZ_WFI;
constexpr size_t WS_WINAB = WS_WFO + 4 * SZ_WFO;
constexpr size_t WS_WOUTAB = WS_WINAB + 24 * MiB;
constexpr size_t WS_WINC = WS_WOUTAB + 8 * MiB;
constexpr size_t WS_WOUTC = WS_WINC + 24 * MiB;
constexpr size_t WS_H = WS_WOUTC + 8 * MiB;
constexpr size_t WS_BIG = WS_H + 130 * MiB;
constexpr size_t WS_ATT = WS_BIG + 390 * MiB;
constexpr size_t WS_MODP = WS_ATT + 130 * MiB;
constexpr size_t WS_MODS = WS_MODP + 18 * MiB;
constexpr size_t WS_FP = WS_MODS + 3 * MiB;
constexpr size_t WS_FS = WS_FP + 1 * MiB;
constexpr size_t WS_O1 = WS_FS + 2 * MiB;
constexpr size_t WS_PART = WS_O1 + 32 * MiB;
constexpr size_t WS_XB = WS_PART + 60 * MiB;
constexpr size_t WS_END = WS_XB + 130 * MiB;

constexpr int CW_BAR = 4096;
constexpr int CW_Q0 = 16384, CW_Q1 = 16384 + 64;
constexpr int CW_KMX = 16384 + 256, CW_KDONE = 16384 + 512;

constexpr int RING_BYTES = 131072;
constexpr int LDSCTL_OFF = RING_BYTES, MISC_OFF = LDSCTL_OFF + 320, PTAB_OFF = LDSCTL_OFF + 1024;
constexpr int LDS_BYTES = 147456;

#define LDS_WAIT() asm volatile("s_waitcnt lgkmcnt(0)" ::: "memory")
#define VM_WAIT() asm volatile("s_waitcnt vmcnt(0)" ::: "memory")
#define SBAR() __builtin_amdgcn_sched_barrier(0)

__device__ __forceinline__ int fresh_tid(int wave_s) { asm volatile("" : "+s"(wave_s)); int l;
    asm volatile("v_mbcnt_lo_u32_b32 %0, -1, 0\n\tv_mbcnt_hi_u32_b32 %0, -1, %0" : "=v"(l));
    return wave_s * 64 + l; }
__device__ __forceinline__ int fresh_s(int x) { asm volatile("" : "+s"(x)); return x; }
__device__ __forceinline__ unsigned cvtpk(float lo, float hi) { unsigned r; asm volatile("v_cvt_pk_bf16_f32 %0, %1, %2" : "=v"(r) : "v"(lo), "v"(hi)); return r; }
__device__ __forceinline__ bf16x8 pack8(f32x4 a, f32x4 b) {
    u32x4 w = {cvtpk(a[0], a[1]), cvtpk(a[2], a[3]), cvtpk(b[0], b[1]), cvtpk(b[2], b[3])};
    return *reinterpret_cast<bf16x8*>(&w);
}
__device__ __forceinline__ float wave_sum(float v) {
#pragma unroll
    for (int o = 1; o < 64; o <<= 1) v += __shfl_xor(v, o);
    return v;
}

namespace pg8 {
#define PG8_LAS __attribute__((address_space(3)))
constexpr int BM = 256, BK = 64, HALF = 128, HTB = HALF * BK * 2, STAGE_BYTES = 8 * HTB, NXCD = 8, WGM = 8;
__host__ __device__ __forceinline__ int lds_byte(int r, int c) { const int st = (r >> 4) * 2 + (c >> 5), rr = r & 15, cc = c & 31, ob = rr * 64 + cc * 2; return st * 1024 + (ob ^ (((ob >> 9) & 1) << 5)); }
__host__ __device__ __forceinline__ void stage_rc(int b, int& R, int& C) { const int st = b / 1024, sb = b % 1024, swz = sb ^ (((sb >> 9) & 1) << 5); R = (st >> 1) * 16 + swz / 64; C = (st & 1) * 32 + (swz % 64) / 2; }
__host__ __device__ __forceinline__ int perm32(int rho) { const int n = rho >> 4, i = rho & 15; return 8 * (i >> 2) + 4 * n + (i & 3); }
struct Unit { int pm, pn, kofs, nt, part; };
struct Gemm { const bf16_t* A; const bf16_t* Bt; int M, N, K; };
struct StaticOrder {
    int nM, nN, nwg, G, c, ntk, wgm;
    __host__ __device__ __forceinline__ void init(int M, int N, int G_, int c_) { nM = M / BM; nN = N / BM; nwg = nM * nN; G = G_; c = c_; ntk = 0; wgm = 4; }
    __host__ __device__ __forceinline__ bool next(int i, Unit& u) const {
        const long L = (long)i * G + c; if (L >= nwg) return false;
        int wgid = (int)L; { const int q = nwg / NXCD, r = nwg % NXCD, xcd = wgid % NXCD, off = wgid / NXCD; wgid = (xcd < r ? xcd * (q + 1) : r * (q + 1) + (xcd - r) * q) + off; }
        const int nig = wgm * nN, gid = wgid / nig, fm = gid * wgm, gsz = (nM - fm) < wgm ? (nM - fm) : wgm;
        u.pm = fm + ((wgid % nig) % gsz); u.pn = (wgid % nig) / gsz; u.kofs = 0; u.nt = ntk; u.part = -1; return true;
    }
    __device__ __forceinline__ void a_ready(const Unit&) const {}
    __device__ __forceinline__ void done(const Unit&) const {}
};
struct SplitOrder {
    StaticOrder so; int S, nitems, base, rem, G, c, npre, nmine;
    __device__ __forceinline__ void init(int Kfull, int N, int S_, int G_, int c_) { so.init(MP, N, G_, c_); so.ntk = Kfull / BK; if (N / BM == 8) so.wgm = 4; S = S_; nitems = 2 * (N / BM) * S; const int chunks = Kfull / 128; base = chunks / S; rem = chunks % S; G = G_; c = c_;
        npre = ((c & 1) && c < nitems) ? 1 : 0; nmine = (so.nwg > c) ? (so.nwg - 1 - c) / G + 1 : 0; }
    __device__ __forceinline__ bool next(int i, Unit& u) const {
        const int j = i - npre;
        if (j >= 0 && j < nmine) return so.next(j, u);
        if (c >= nitems || !((npre && i == 0) || (!npre && j == nmine))) return false;
        const int unit = c / S, s = c % S, start = s * base + (s < rem ? s : rem), len = base + (s < rem ? 1 : 0);
        u.pm = MP / BM + unit / (so.nN); u.pn = unit % so.nN; u.kofs = start * 128; u.nt = len * 2; u.part = s; return true;
    }
    __device__ __forceinline__ void a_ready(const Unit&) const {}
    __device__ __forceinline__ void done(const Unit&) const {}
};
template <class Epi, class Sched, bool ALIGN_EPI = false, bool SP2 = false>
__device__ __forceinline__ void gemm_phase(PG8_LAS unsigned char* lds, const Gemm g, const Sched& S, const Epi& E, int wave_s) {
    const int tid = fresh_tid(wave_s), wid = __builtin_amdgcn_readfirstlane(tid >> 6), lane = tid & 63, wr = wid >> 2, wc = wid & 3, fr = lane & 15, fq = lane >> 4;
    const int K = g.K;
    unsigned voffA[2], voffB[2];
#pragma unroll
    for (int i = 0; i < 2; ++i) { int R, C; stage_rc(tid * 16 + i * 8192, R, C); const int Rb = Epi::PERM ? ((R & ~31) + perm32(R & 31)) : R;
        voffA[i] = (unsigned)(R * K + C) * 2u; voffB[i] = (unsigned)(Rb * K + C) * 2u; }
    const size_t kstep = (size_t)(BK * 2);
    const size_t hstep = (size_t)HALF * K * 2;
    const size_t tstep = 2 * hstep;
    const unsigned ldsw = (unsigned)wid * 1024u;
    const int aoff = lds_byte(wr * 64 + fr, fq * 8), boff = lds_byte(wc * 32 + fr, fq * 8);
#define PG8_SA(b, h) (((b) * 2 + (h)) * HTB)
#define PG8_SB(b, h) ((4 + (b) * 2 + (h)) * HTB)
#define PG8_STAGE(bufoff, gbase, voff) do { _Pragma("unroll") for (int _i = 0; _i < 2; ++_i) \
        __builtin_amdgcn_global_load_lds((const unsigned*)((const char*)(gbase) + (voff)[_i]), (PG8_LAS unsigned*)(lds + (bufoff) + ldsw + _i * 8192), 16, 0, 0); } while (0)
#define PG8_LDA(dst, b, h) do { _Pragma("unroll") for (int m = 0; m < 4; ++m) _Pragma("unroll") for (int k = 0; k < 2; ++k) dst[m][k] = *(const PG8_LAS bf16x8*)(lds + PG8_SA(b, h) + aoff + m * 2048 + k * 1024); } while (0)
#define PG8_LDB(dst, b, h) do { _Pragma("unroll") for (int n = 0; n < 2; ++n) _Pragma("unroll") for (int k = 0; k < 2; ++k) dst[n][k] = *(const PG8_LAS bf16x8*)(lds + PG8_SB(b, h) + boff + n * 2048 + k * 1024); } while (0)
#define PG8_MMA(ai, bj, At, Bt) do { __builtin_amdgcn_s_setprio(1); _Pragma("unroll") for (int m = 0; m < 4; ++m) _Pragma("unroll") for (int n = 0; n < 2; ++n) _Pragma("unroll") for (int k = 0; k < 2; ++k) \
        acc[ai][bj][m][n] = __builtin_amdgcn_mfma_f32_16x16x32_bf16(Bt[n][k], At[m][k], acc[ai][bj][m][n], 0, 0, 0); __builtin_amdgcn_s_setprio(0); } while (0)
#define PG8_WAIT_V(n) asm volatile("s_waitcnt vmcnt(" #n ")" ::: "memory")
#define PG8_WAIT_L(n) asm volatile("s_waitcnt lgkmcnt(" #n ")" ::: "memory")
#define PG8_BAR __builtin_amdgcn_s_barrier()
#define PG8_SCHED __builtin_amdgcn_sched_barrier(0)
    Unit cur, nxt; int ui = 0;
    if (!S.next(0, cur)) return;
    f32x4 acc[2][2][4][2];
#pragma unroll
    for (int a = 0; a < 2; ++a)
#pragma unroll
        for (int b = 0; b < 2; ++b)
#pragma unroll
            for (int m = 0; m < 4; ++m)
#pragma unroll
                for (int n = 0; n < 2; ++n) acc[a][b][m][n] = (f32x4){0.f, 0.f, 0.f, 0.f};
    bf16x8 At[4][2], B0[2][2], B1[2][2];
    int nt = cur.nt;
    const char* cA = (const char*)g.A + (size_t)cur.pm * tstep + (size_t)cur.kofs * 2; const char* cB = (const char*)g.Bt + (size_t)cur.pn * tstep + (size_t)cur.kofs * 2;
    S.a_ready(cur);
    if constexpr (SP2) {
        PG8_STAGE(PG8_SB(0, 0), cB, voffB); PG8_STAGE(PG8_SB(0, 1), cB + hstep, voffB); PG8_STAGE(PG8_SA(0, 0), cA, voffA); PG8_STAGE(PG8_SA(0, 1), cA + hstep, voffA);
        if (wr == 1) PG8_BAR;
        PG8_WAIT_V(2); PG8_BAR;
        PG8_STAGE(PG8_SB(1, 0), cB + kstep, voffB); PG8_STAGE(PG8_SA(1, 0), cA + kstep, voffA); PG8_STAGE(PG8_SB(1, 1), cB + hstep + kstep, voffB);
        PG8_WAIT_V(6); PG8_BAR;
    } else {
        PG8_STAGE(PG8_SB(0, 0), cB, voffB); PG8_STAGE(PG8_SA(0, 0), cA, voffA); PG8_STAGE(PG8_SB(0, 1), cB + hstep, voffB); PG8_STAGE(PG8_SA(0, 1), cA + hstep, voffA);
        if (wr == 1) PG8_BAR;
        PG8_WAIT_V(4); PG8_BAR;
        PG8_STAGE(PG8_SB(1, 0), cB + kstep, voffB); PG8_STAGE(PG8_SA(1, 0), cA + kstep, voffA); PG8_STAGE(PG8_SB(1, 1), cB + hstep + kstep, voffB);
        PG8_WAIT_V(6); PG8_BAR;
    }
    for (;;) {
        const bool has_next = S.next(ui + 1, nxt);
        const char* nA = has_next ? (const char*)g.A + (size_t)nxt.pm * tstep + (size_t)nxt.kofs * 2 : cA; const char* nB = has_next ? (const char*)g.Bt + (size_t)nxt.pn * tstep + (size_t)nxt.kofs * 2 : cB;
        for (int t = 0; t < nt; t += 2) {
            const bool last = (t == nt - 2);
            const char* a1 = cA + (size_t)(t + 1) * kstep;
            const char* a2 = last ? nA : cA + (size_t)(t + 2) * kstep; const char* b2 = last ? nB : cB + (size_t)(t + 2) * kstep;
            const char* a3 = a2 + kstep; const char* b3 = b2 + kstep;
            if (last && has_next) S.a_ready(nxt);
            if constexpr (SP2) {
            PG8_LDB(B0, 0, 0); PG8_LDB(B1, 0, 1); PG8_SCHED; PG8_LDA(At, 0, 0); PG8_STAGE(PG8_SA(1, 1), a1 + hstep, voffA);
            PG8_WAIT_V(8); PG8_WAIT_L(0); PG8_BAR; PG8_MMA(0, 0, At, B0); PG8_MMA(0, 1, At, B1); PG8_BAR; PG8_SCHED;
            PG8_LDA(At, 0, 1); PG8_STAGE(PG8_SB(0, 0), b2, voffB); PG8_STAGE(PG8_SB(0, 1), b2 + hstep, voffB); PG8_STAGE(PG8_SA(0, 0), a2, voffA);
            PG8_WAIT_V(8); PG8_WAIT_L(0); PG8_BAR; PG8_MMA(1, 0, At, B0); PG8_MMA(1, 1, At, B1); PG8_BAR; PG8_SCHED;
            PG8_LDB(B0, 1, 0); PG8_LDB(B1, 1, 1); PG8_SCHED; PG8_LDA(At, 1, 0); PG8_STAGE(PG8_SA(0, 1), a2 + hstep, voffA);
            PG8_WAIT_V(8); PG8_WAIT_L(0); PG8_BAR; PG8_MMA(0, 0, At, B0); PG8_MMA(0, 1, At, B1); PG8_BAR; PG8_SCHED;
            PG8_LDA(At, 1, 1); PG8_STAGE(PG8_SB(1, 0), b3, voffB); PG8_STAGE(PG8_SB(1, 1), b3 + hstep, voffB); PG8_STAGE(PG8_SA(1, 0), a3, voffA);
            PG8_WAIT_V(8); PG8_WAIT_L(0); PG8_BAR; PG8_MMA(1, 0, At, B0); PG8_MMA(1, 1, At, B1); PG8_BAR; PG8_SCHED;
            } else {
            PG8_LDB(B0, 0, 0); PG8_SCHED; PG8_LDA(At, 0, 0); PG8_STAGE(PG8_SA(1, 1), a1 + hstep, voffA);
            PG8_WAIT_L(8); PG8_BAR; PG8_WAIT_L(0); PG8_MMA(0, 0, At, B0); PG8_BAR; PG8_SCHED;
            PG8_LDB(B1, 0, 1); PG8_STAGE(PG8_SB(0, 0), b2, voffB);
            PG8_BAR; PG8_WAIT_L(0); PG8_MMA(0, 1, At, B1); PG8_BAR;
            PG8_LDA(At, 0, 1); PG8_STAGE(PG8_SA(0, 0), a2, voffA);
            PG8_BAR; PG8_WAIT_L(0); PG8_MMA(1, 0, At, B0); PG8_BAR; PG8_SCHED;
            PG8_STAGE(PG8_SB(0, 1), b2 + hstep, voffB);
            PG8_WAIT_V(6); PG8_BAR; PG8_MMA(1, 1, At, B1); PG8_BAR;
            PG8_LDB(B0, 1, 0); PG8_SCHED; PG8_LDA(At, 1, 0); PG8_STAGE(PG8_SA(0, 1), a2 + hstep, voffA);
            PG8_WAIT_L(8); PG8_BAR; PG8_WAIT_L(0); PG8_MMA(0, 0, At, B0); PG8_BAR; PG8_SCHED;
            PG8_LDB(B1, 1, 1); PG8_STAGE(PG8_SB(1, 0), b3, voffB);
            PG8_BAR; PG8_WAIT_L(0); PG8_MMA(0, 1, At, B1); PG8_BAR;
            PG8_LDA(At, 1, 1); PG8_STAGE(PG8_SA(1, 0), a3, voffA);
            PG8_BAR; PG8_WAIT_L(0); PG8_MMA(1, 0, At, B0); PG8_BAR; PG8_SCHED;
            PG8_STAGE(PG8_SB(1, 1), b3 + hstep, voffB);
            PG8_WAIT_V(6); PG8_BAR; PG8_MMA(1, 1, At, B1); PG8_BAR;
            }
        }
        if constexpr (ALIGN_EPI) { if (wr == 0) PG8_BAR; }
        E(acc, cur, wr, wc, fr, fq);
        if (!has_next) break;
#pragma unroll
        for (int a = 0; a < 2; ++a)
#pragma unroll
            for (int b = 0; b < 2; ++b)
#pragma unroll
                for (int m = 0; m < 4; ++m)
#pragma unroll
                    for (int n = 0; n < 2; ++n) acc[a][b][m][n] = (f32x4){0.f, 0.f, 0.f, 0.f};
        cur = nxt; cA = nA; cB = nB; ++ui; nt = cur.nt;
        if constexpr (ALIGN_EPI) { if (wr == 1) PG8_BAR; }
    }
    PG8_WAIT_V(0);
    if constexpr (!ALIGN_EPI) { if (wr == 0) PG8_BAR; }
    PG8_BAR;
#undef PG8_SA
#undef PG8_SB
#undef PG8_STAGE
#undef PG8_LDA
#undef PG8_LDB
#undef PG8_MMA
#undef PG8_WAIT_V
#undef PG8_WAIT_L
#undef PG8_BAR
#undef PG8_SCHED
}
}

struct EpiSwiGLU {
    static constexpr bool PERM = true;
    bf16_t* O;
    __device__ __forceinline__ void operator()(const f32x4 (&acc)[2][2][4][2], const pg8::Unit& u, int wr, int wc, int fr, int fq) const {
        const int row0 = u.pm * 256 + wr * 64 + fr, col0 = u.pn * 128 + wc * 32 + 8 * fq;
#pragma unroll
        for (int ai = 0; ai < 2; ++ai)
#pragma unroll
            for (int m = 0; m < 4; ++m) {
                bf16_t* rowp = O + (size_t)(row0 + ai * 128 + m * 16) * DFF + col0;
                float v[8];
#pragma unroll
                for (int n = 0; n < 2; ++n)
#pragma unroll
                    for (int j = 0; j < 4; ++j) {
                        const float t = acc[ai][0][m][n][j], uu = acc[ai][1][m][n][j];
                        v[n * 4 + j] = (t * uu) * __builtin_amdgcn_rcpf(1.0f + __builtin_amdgcn_exp2f(t));
                    }
                u32x4 w; w.x = cvtpk(v[0], v[1]); w.y = cvtpk(v[2], v[3]); w.z = cvtpk(v[4], v[5]); w.w = cvtpk(v[6], v[7]);
                *(u32x4*)rowp = w;
            }
    }
};
struct EpiResGate {
    static constexpr bool PERM = true;
    const float* xin_p;
    bf16_t* xb;
    const float* gate;
    float coef;
    float* part;
    __device__ __forceinline__ void operator()(const f32x4 (&acc)[2][2][4][2], const pg8::Unit& u, int wr, int wc, int fr, int fq) const {
        const int row0 = u.pm * 256 + wr * 64 + fr, col0 = u.pn * 256 + wc * 32 + 8 * fq;
        if (u.part >= 0) {
            float* pp = part + ((size_t)u.part * MS + (row0 - MP)) * DM + col0;
#pragma unroll
            for (int ai = 0; ai < 2; ++ai)
#pragma unroll
                for (int m = 0; m < 4; ++m)
#pragma unroll
                    for (int bj = 0; bj < 2; ++bj)
#pragma unroll
                        for (int n = 0; n < 2; ++n) *(f32x4*)(pp + (size_t)(ai * 128 + m * 16) * DM + bj * 128 + n * 4) = acc[ai][bj][m][n];
            return;
        }
        const int modrow = u.pm >> 4;
        const float* gp = gate + (size_t)modrow * NADA + col0;
        f32x4 gv[2][2];
#pragma unroll
        for (int bj = 0; bj < 2; ++bj)
#pragma unroll
            for (int n = 0; n < 2; ++n) gv[bj][n] = *(const f32x4*)(gp + bj * 128 + n * 4) * coef;
#pragma unroll
        for (int ai = 0; ai < 2; ++ai)
#pragma unroll
            for (int m = 0; m < 4; ++m) {
                const size_t off = (size_t)(row0 + ai * 128 + m * 16) * DM + col0;
#pragma unroll
                for (int bj = 0; bj < 2; ++bj) {
                    f32x4 x0, x1;
                    if (xin_p) { x0 = *(const f32x4*)(xin_p + off + bj * 128); x1 = *(const f32x4*)(xin_p + off + bj * 128 + 4); }
                    else { const u32x4 w = *(const u32x4*)(xb + off + bj * 128);
                        x0 = (f32x4){__uint_as_float(w.x << 16), __uint_as_float(w.x & 0xffff0000u), __uint_as_float(w.y << 16), __uint_as_float(w.y & 0xffff0000u)};
                        x1 = (f32x4){__uint_as_float(w.z << 16), __uint_as_float(w.z & 0xffff0000u), __uint_as_float(w.w << 16), __uint_as_float(w.w & 0xffff0000u)}; }
                    x0 += gv[bj][0] * acc[ai][bj][m][0]; x1 += gv[bj][1] * acc[ai][bj][m][1];
                    u32x4 o; o.x = cvtpk(x0[0], x0[1]); o.y = cvtpk(x0[2], x0[3]); o.z = cvtpk(x1[0], x1[1]); o.w = cvtpk(x1[2], x1[3]);
                    *(u32x4*)(xb + off + bj * 128) = o;
                }
            }
    }
};
struct EpiQKV {
    static constexpr bool PERM = true;
    bf16_t* O;
    float* out;
    int layer1;
    float* part;
    __device__ __forceinline__ void operator()(const f32x4 (&acc)[2][2][4][2], const pg8::Unit& u, int wr, int wc, int fr, int fq) const {
        if (u.part >= 0) {
            float* pp = part + ((size_t)u.part * MS + (u.pm * 256 - MP + wr * 64 + fr)) * NQKV + u.pn * 256 + wc * 32 + 8 * fq;
#pragma unroll
            for (int ai = 0; ai < 2; ++ai)
#pragma unroll
                for (int m = 0; m < 4; ++m)
#pragma unroll
                    for (int bj = 0; bj < 2; ++bj)
#pragma unroll
                        for (int n = 0; n < 2; ++n) *(f32x4*)(pp + (size_t)(ai * 128 + m * 16) * NQKV + bj * 128 + n * 4) = acc[ai][bj][m][n];
            return;
        }
        const int sh = layer1 ? 3 : 2;
        const int sec = u.pn >> sh, colw = (u.pn & ((1 << sh) - 1)) * 256, ldf = 256 << sh;
        const int row0 = u.pm * 256 + wr * 64 + fr, cw = wc * 32 + 8 * fq;
        const bool samp = u.pm >= 128;
        size_t fo = 0;
        if (!layer1) { if (sec == 1) fo = samp ? OFF_AKS : OFF_AKP; else if (sec == 2) fo = samp ? OFF_AVS : OFF_AVP; else if (sec == 4) fo = samp ? OFF_BKS : OFF_BKP; else if (sec == 5) fo = samp ? OFF_BVS : OFF_BVP; }
        else { if (sec == 1) fo = samp ? OFF_CKS : OFF_CKP; else if (sec == 2) fo = samp ? OFF_CVS : OFF_CVP; }
        float* fdst = nullptr;
        if (fo) {
            if (samp) fdst = out + fo + (size_t)(u.pm * 256 - MP) * ldf;
            else if (!layer1) fdst = out + fo + (size_t)(u.pm * 256) * ldf;
            else if ((u.pm & 15) >= 14) { const int b = u.pm >> 4; fdst = out + fo + (size_t)(u.pm * 256 - (b + 1) * 3584) * ldf; }
        }
#pragma unroll
        for (int ai = 0; ai < 2; ++ai)
#pragma unroll
            for (int m = 0; m < 4; ++m) {
                const int rl = ai * 128 + m * 16;
                bf16_t* rowp = O + (size_t)(row0 + rl) * NQKV + u.pn * 256 + cw;
#pragma unroll
                for (int bj = 0; bj < 2; ++bj) {
                    const f32x4 v0 = acc[ai][bj][m][0], v1 = acc[ai][bj][m][1];
                    u32x4 w; w.x = cvtpk(v0[0], v0[1]); w.y = cvtpk(v0[2], v0[3]); w.z = cvtpk(v1[0], v1[1]); w.w = cvtpk(v1[2], v1[3]);
                    *(u32x4*)(rowp + bj * 128) = w;
                    if (fdst) { float* fr_ = fdst + (size_t)(wr * 64 + fr + rl) * ldf + colw + bj * 128 + cw;
                        __builtin_nontemporal_store(v0, (f32x4*)fr_); __builtin_nontemporal_store(v1, (f32x4*)(fr_ + 4)); }
                }
            }
    }
};

#define XB_TMO      128
#define XB_XCNT(j)  (256  + 64 * (j))
#define XB_XSUB(j)  (1280 + 64 * (j))
#define XB_XGEN(j)  (2304 + 64 * (j))
#define XB_TOP      3328
#define XB_TOPGEN   3392
#define XCD_BAR_WORDS 3456
#define XB_SPIN_CAP (1u << 18)
__device__ __forceinline__ unsigned xb_ld(unsigned* p)              { return __hip_atomic_load(p, __ATOMIC_RELAXED, __HIP_MEMORY_SCOPE_AGENT); }
__device__ __forceinline__ unsigned xb_add(unsigned* p, unsigned v) { return __hip_atomic_fetch_add(p, v, __ATOMIC_RELAXED, __HIP_MEMORY_SCOPE_AGENT); }
__device__ __forceinline__ unsigned xb_xcc_id() { return (unsigned)__builtin_amdgcn_s_getreg((3 << 11) | 20) & 0xFu; }
#define XB_SPIN(cond, bar) do { unsigned _sp = 0; while (cond) { __builtin_amdgcn_s_sleep(1); \
    if ((++_sp & 255u) == 0u) { if (xb_ld(&(bar)[XB_TMO])) break; if (_sp > XB_SPIN_CAP) { atomicAdd(&(bar)[XB_TMO], 1u); break; } } } } while (0)
struct XcdBarrier { unsigned* bar; unsigned x; volatile LAS unsigned* st; };
__device__ __forceinline__ XcdBarrier xcd_barrier_post(unsigned* bar, volatile LAS unsigned* st, int tid) {
    XcdBarrier b; b.bar = bar; b.x = xb_xcc_id(); b.st = st;
    if (tid == 0) (void)xb_add(&bar[XB_XCNT(b.x)], 1u);
    return b;
}
__device__ __forceinline__ void xcd_barrier_complete(unsigned* bar, unsigned x, unsigned& nloc, unsigned& nx) {
    const unsigned G = gridDim.x * gridDim.y * gridDim.z;
    unsigned sum, cnt, mine, sp = 0u;
    for (;;) {
        sum = 0u; cnt = 0u; mine = 0u;
#pragma unroll
        for (unsigned j = 0; j < 16; ++j) { const unsigned c = xb_ld(&bar[XB_XCNT(j)]); sum += c; cnt += (c > 0u) ? 1u : 0u; }
        mine = xb_ld(&bar[XB_XCNT(x)]);
        if (sum == G) break;
        __builtin_amdgcn_s_sleep(1);
        if ((++sp & 255u) == 0u) { if (xb_ld(&bar[XB_TMO])) break; if (sp > XB_SPIN_CAP) { atomicAdd(&bar[XB_TMO], 1u); break; } }
    }
    nloc = mine > 0u ? mine : 1u; nx = cnt > 0u ? cnt : 1u;
}
__device__ __forceinline__ void xcd_barrier(const XcdBarrier& b, int tid) {
    asm volatile("s_waitcnt vmcnt(0)" ::: "memory");
    __syncthreads();
    if (tid == 0) {
        unsigned* bar = b.bar; asm volatile("" : "+s"(bar));
        __builtin_amdgcn_s_waitcnt(0);
        unsigned nloc = b.st[0], nx = b.st[1];
        if (nloc == 0u) { xcd_barrier_complete(bar, b.x, nloc, nx); b.st[0] = nloc; b.st[1] = nx; }
        const unsigned old = xb_add(&bar[XB_XSUB(b.x)], 1u);
        const unsigned gen = old / nloc;
        if (old + 1u == (gen + 1u) * nloc) {
            __builtin_amdgcn_fence(__ATOMIC_RELEASE, "agent");
            asm volatile("s_waitcnt vmcnt(0)" ::: "memory");
            const unsigned og = xb_add(&bar[XB_TOP], 1u);
            const unsigned tg = og / nx;
            if (og + 1u == (tg + 1u) * nx) xb_add(&bar[XB_TOPGEN], 1u);
            else XB_SPIN(xb_ld(&bar[XB_TOPGEN]) == tg, bar);
            __builtin_amdgcn_fence(__ATOMIC_ACQUIRE, "agent");
            xb_add(&bar[XB_XGEN(b.x)], 1u);
            asm volatile("s_waitcnt vmcnt(0)" ::: "memory");
        } else {
            XB_SPIN(xb_ld(&bar[XB_XGEN(b.x)]) == gen, bar);
            __builtin_amdgcn_fence(__ATOMIC_ACQUIRE, "agent");
            asm volatile("s_waitcnt vmcnt(0)" ::: "memory");
        }
    }
    __syncthreads();
}

__device__ __forceinline__ void transpose_block(const float* W, int ldw, int K, bf16_t* WT, int k0, int n0, int swiglu, int lane) {
    const int a = lane & 15, g = lane >> 4;
    const float* src = W + (size_t)(k0 + 16 * g) * ldw + n0 + 4 * a;
    f32x4 v[16];
#pragma unroll
    for (int kk = 0; kk < 16; ++kk) v[kk] = *(const f32x4*)(src + (size_t)kk * ldw);
#pragma unroll
    for (int j = 0; j < 4; ++j) {
        const int n = n0 + 4 * a + j;
        int R = n;
        if (swiglu == 1) { R = (n < DFF) ? ((n >> 7) * 256 + (n & 127)) : (((n - DFF) >> 7) * 256 + 128 + ((n - DFF) & 127));
            const float sc = (n < DFF) ? -LOG2E : -1.0f / LOG2E;
#pragma unroll
            for (int kk = 0; kk < 16; ++kk) v[kk][j] *= sc; }
        if (swiglu >= 2) {
            const float sc = (swiglu == 2) ? ((n < 1024) ? QSCALE_A : ((n >= 3072 && n < 4096) ? QSCALE_B : 1.0f)) : ((n < 2048) ? QSCALE_B : 1.0f);
#pragma unroll
            for (int kk = 0; kk < 16; ++kk) v[kk][j] *= sc; }
        u32x4 w0, w1;
        w0.x = cvtpk(v[0][j], v[1][j]); w0.y = cvtpk(v[2][j], v[3][j]); w0.z = cvtpk(v[4][j], v[5][j]); w0.w = cvtpk(v[6][j], v[7][j]);
        w1.x = cvtpk(v[8][j], v[9][j]); w1.y = cvtpk(v[10][j], v[11][j]); w1.z = cvtpk(v[12][j], v[13][j]); w1.w = cvtpk(v[14][j], v[15][j]);
        bf16_t* dst = WT + (size_t)R * K + k0 + 16 * g;
        *(u32x4*)dst = w0; *(u32x4*)(dst + 8) = w1;
    }
}
struct InPtrs { const float* p[29]; };
__device__ __forceinline__ const float* inp(LAS unsigned char* lds, int i) {
    int off = PTAB_OFF + 8 * i; asm volatile("" : "+v"(off));
    const unsigned long long v = *(volatile LAS unsigned long long*)(lds + off);
    const unsigned lo = __builtin_amdgcn_readfirstlane((unsigned)v), hi = __builtin_amdgcn_readfirstlane((unsigned)(v >> 32));
    return (const float*)(((unsigned long long)hi << 32) | lo);
}

__device__ __forceinline__ void prologue_phase(unsigned char* ws, LAS unsigned char* lds, int G, int wg, int tid, int wave, int lane) {
    const float* w_ada = inp(lds, 11); const float* c_p = inp(lds, 9); const float* c_s = inp(lds, 10);
    float* modp = (float*)(ws + WS_MODP);
    LAS float* sct = (LAS float*)lds;
    LAS f32x4* red = (LAS f32x4*)(lds + 16384);
    for (int u = wg; u < 1152; u += G) {
        const int l = u / 576, r = u % 576, cb = r >> 3, k8 = r & 7, k0 = k8 * 256;
        __syncthreads();
        if (tid < 256) {
            const int k = k0 + tid;
#pragma unroll
            for (int rr = 0; rr < 16; ++rr) { const float c = (rr < 8) ? c_p[rr * DM + k] : c_s[(rr - 8) * DM + k];
                sct[tid * 16 + rr] = c / (1.0f + __expf(-c)); }
        }
        __syncthreads();
        f32x4 acc[16];
#pragma unroll
        for (int rr = 0; rr < 16; ++rr) acc[rr] = (f32x4){0.f, 0.f, 0.f, 0.f};
        const float* wp = w_ada + ((size_t)l * DM + k0 + wave * 32) * NADA + cb * 256 + 4 * lane;
#pragma unroll 4
        for (int kk = 0; kk < 32; ++kk) {
            const f32x4 wv = *(const f32x4*)(wp + (size_t)kk * NADA);
            const LAS f32x4* sp = (const LAS f32x4*)(sct + (wave * 32 + kk) * 16);
            const f32x4 s0 = sp[0], s1 = sp[1], s2 = sp[2], s3 = sp[3];
#pragma unroll
            for (int e = 0; e < 4; ++e) { acc[e] += wv * s0[e]; acc[4 + e] += wv * s1[e]; acc[8 + e] += wv * s2[e]; acc[12 + e] += wv * s3[e]; }
        }
#pragma unroll
        for (int p = 0; p < 2; ++p) {
#pragma unroll
            for (int i = 0; i < 8; ++i) red[(wave * 8 + i) * 64 + lane] = acc[p * 8 + i];
            __syncthreads();
            { const int i = tid >> 6, ln = tid & 63; f32x4 s = red[i * 64 + ln];
#pragma unroll
              for (int w = 1; w < 8; ++w) s += red[(w * 8 + i) * 64 + ln];
              *(f32x4*)(modp + ((size_t)((k8 * 2 + l) * 16 + p * 8 + i)) * NADA + cb * 256 + 4 * ln) = s; }
            __syncthreads();
        }
    }
    constexpr int NB_FI = 32 * 172, NB_FO = 86 * 32, NB_IN = 32 * 96, NB_OUT = 32 * 32;
    constexpr int TOT = 4 * NB_FI + 4 * NB_FO + 2 * NB_IN + 2 * NB_OUT;
    for (int gb = wg * 8 + wave; gb < TOT; gb += G * 8) {
        int g = gb; const float* W; int ldw, K, nb64, swi = 0; bf16_t* WT;
        if (g < 4 * NB_FI) { const int m = g / NB_FI; g -= m * NB_FI; W = inp(lds, 14) + (size_t)m * DM * 11008; ldw = 11008; K = DM; nb64 = 172; swi = 1; WT = (bf16_t*)(ws + WS_WFI + (size_t)m * SZ_WFI); }
        else { g -= 4 * NB_FI;
            if (g < 4 * NB_FO) { const int m = g / NB_FO; g -= m * NB_FO; W = inp(lds, 15) + (size_t)m * DFF * DM; ldw = DM; K = DFF; nb64 = 32; WT = (bf16_t*)(ws + WS_WFO + (size_t)m * SZ_WFO); }
            else { g -= 4 * NB_FO;
                if (g < NB_IN) { W = inp(lds, 16); ldw = LD_WINAB; K = DM; nb64 = 96; swi = 2; WT = (bf16_t*)(ws + WS_WINAB); }
                else { g -= NB_IN;
                    if (g < NB_OUT) { W = inp(lds, 18); ldw = DM; K = DM; nb64 = 32; WT = (bf16_t*)(ws + WS_WOUTAB); }
                    else { g -= NB_OUT;
                        if (g < NB_IN) { W = inp(lds, 25); ldw = NQKV; K = DM; nb64 = 96; swi = 3; WT = (bf16_t*)(ws + WS_WINC); }
                        else { g -= NB_IN; W = inp(lds, 26); ldw = DM; K = DM; nb64 = 32; WT = (bf16_t*)(ws + WS_WOUTC); } } } } }
        const int kb = g / nb64, nb = g % nb64;
        transpose_block(W, ldw, K, WT, kb * 64, nb * 64, swi, lane);
    }
}
__device__ __forceinline__ void mods_finalize(LAS unsigned char* lds, unsigned char* ws, int G, int wg, int tid) {
    const float* modp = (const float*)(ws + WS_MODP); float* mods = (float*)(ws + WS_MODS); const float* b_ada = inp(lds, 12);
    constexpr int NV = 2 * 16 * NADA / 4;
    for (int i = wg * 512 + tid; i < NV; i += G * 512) {
        const int e = i * 4, l = e / (16 * NADA), rem = e % (16 * NADA), r = rem / NADA, j = rem % NADA;
        f32x4 s = *(const f32x4*)(b_ada + (size_t)l * NADA + j);
#pragma unroll
        for (int k8 = 0; k8 < 8; ++k8) s += *(const f32x4*)(modp + ((size_t)((k8 * 2 + l) * 16 + r)) * NADA + j);
        *(f32x4*)(mods + e) = s;
    }
}

__device__ __forceinline__ void load_row(f32x4 (&v)[8], const float* x32, const bf16_t* xb, int lane) {
    if (x32) {
#pragma unroll
        for (int j = 0; j < 8; ++j) v[j] = *(const f32x4*)(x32 + 4 * lane + 256 * j);
    } else {
#pragma unroll
        for (int j = 0; j < 8; ++j) { const u32x2 w = *(const u32x2*)(xb + 4 * lane + 256 * j);
            v[j] = (f32x4){__uint_as_float(w.x << 16), __uint_as_float(w.x & 0xffff0000u), __uint_as_float(w.y << 16), __uint_as_float(w.y & 0xffff0000u)}; }
    }
}
struct SampleFix { const float* part; int S; const float* gate; float coef; };
__device__ __forceinline__ void sample_fix(f32x4 (&v)[8], const SampleFix& fx, int srow, bf16_t* xb_row, int lane) {
    f32x4 acc[8];
#pragma unroll
    for (int j = 0; j < 8; ++j) acc[j] = (f32x4){0.f, 0.f, 0.f, 0.f};
#pragma unroll 1
    for (int sl = 0; sl < fx.S; ++sl) { const float* pp = fx.part + ((size_t)sl * MS + srow) * DM + 4 * lane;
#pragma unroll
        for (int j = 0; j < 8; ++j) acc[j] += *(const f32x4*)(pp + 256 * j); }
    const float* gp = fx.gate + (size_t)(8 + (srow >> 6)) * NADA + 4 * lane;
#pragma unroll
    for (int j = 0; j < 8; ++j) { v[j] += *(const f32x4*)(gp + 256 * j) * fx.coef * acc[j];
        u32x2 w; w.x = cvtpk(v[j][0], v[j][1]); w.y = cvtpk(v[j][2], v[j][3]);
        *(u32x2*)(xb_row + 4 * lane + 256 * j) = w;
        v[j] = (f32x4){__uint_as_float(w.x << 16), __uint_as_float(w.x & 0xffff0000u), __uint_as_float(w.y << 16), __uint_as_float(w.y & 0xffff0000u)}; }
}
template <bool FGATE>
__device__ __forceinline__ void norm_row(f32x4 (&v)[8], bf16_t* hrow, const f32x4 (&gs)[8], const f32x4 (&sh)[8], int lane,
                                         const LAS f32x4* wfA, const LAS f32x4* wfB, const float* bf, float* fout) {
    float ss = 0.f;
#pragma unroll
    for (int j = 0; j < 8; ++j) ss += (v[j][0] * v[j][0] + v[j][1] * v[j][1]) + (v[j][2] * v[j][2] + v[j][3] * v[j][3]);
    const float rstd = 1.0f / sqrtf(wave_sum(ss) * (1.0f / DM) + EPS);
#pragma unroll
    for (int j = 0; j < 8; ++j) { v[j] = v[j] * rstd * gs[j] + sh[j];
        u32x2 w; w.x = cvtpk(v[j][0], v[j][1]); w.y = cvtpk(v[j][2], v[j][3]);
        *(u32x2*)(hrow + 4 * lane + 256 * j) = w; }
    if constexpr (FGATE) {
        f32x4 fa = {0.f, 0.f, 0.f, 0.f}, fb = {0.f, 0.f, 0.f, 0.f};
#pragma unroll
        for (int j = 0; j < 8; ++j)
#pragma unroll
            for (int e = 0; e < 4; ++e) { const f32x4 a = wfA[(j * 4 + e) * 64 + lane], b = wfB[(j * 4 + e) * 64 + lane]; fa += a * v[j][e]; fb += b * v[j][e]; }
        float z[8];
#pragma unroll
        for (int e = 0; e < 4; ++e) { z[e] = wave_sum(fa[e]); z[4 + e] = wave_sum(fb[e]); }
        float zz = z[0];
#pragma unroll
        for (int e = 1; e < 8; ++e) zz = (lane == e) ? z[e] : zz;
        if (lane < 8) { zz += bf[lane]; const float lf = fminf(zz, 0.f) - log1pf(expf(-fabsf(zz))); fout[lane] = lf; }
    }
}
template <bool FGATE>
__device__ __forceinline__ void norm_phase(const float* xp32, const float* xs32, bf16_t* xb, const float* g, const float* mods_l, int chunk, bf16_t* H,
                                           const float* wf_src, const float* bf, float* out, const SampleFix fx, LAS unsigned char* lds, int G, int wg, int tid, int wave, int lane) {
    const LAS f32x4* wfA = (const LAS f32x4*)lds; const LAS f32x4* wfB = (const LAS f32x4*)(lds + 32768);
    if constexpr (FGATE) {
        for (int c = tid; c < DM; c += 512) { const int j = c >> 8, ln = (c & 255) >> 2, e = c & 3, idx = (j * 4 + e) * 64 + ln;
            const float* s = wf_src + (size_t)c * LD_WINAB + 6144;
            ((LAS f32x4*)lds)[idx] = *(const f32x4*)s; ((LAS f32x4*)(lds + 32768))[idx] = *(const f32x4*)(s + 4); }
        __syncthreads();
    }
    f32x4 gs[8], sh[8], v[8], v2[8];
    for (int blk = wg; blk < 256; blk += G) {
        const int b = blk >> 5, r0 = b * SEQ + (blk & 31) * 128 + wave * 16;
        const float* shp = mods_l + (size_t)b * NADA + chunk * DM; const float* scp = shp + DM;
#pragma unroll
        for (int j = 0; j < 8; ++j) { const int c = 4 * lane + 256 * j; gs[j] = *(const f32x4*)(g + c) * (*(const f32x4*)(scp + c) + 1.0f); sh[j] = *(const f32x4*)(shp + c); }
        for (int i = 0; i < 16; i += 2) { const int row = r0 + i;
            load_row(v, xp32 ? xp32 + (size_t)row * DM : nullptr, xb + (size_t)row * DM, lane);
            load_row(v2, xp32 ? xp32 + (size_t)(row + 1) * DM : nullptr, xb + (size_t)(row + 1) * DM, lane);
            norm_row<FGATE>(v, H + (size_t)row * DM, gs, sh, lane, wfA, wfB, bf, FGATE ? out + OFF_BFP + (size_t)row * 8 : nullptr);
            norm_row<FGATE>(v2, H + (size_t)(row + 1) * DM, gs, sh, lane, wfA, wfB, bf, FGATE ? out + OFF_BFP + (size_t)(row + 1) * 8 : nullptr); }
    }
    for (int s = wave * G + wg; s < MS; s += 8 * G) {
        const int mr = 8 + (s >> 6);
        const float* shp = mods_l + (size_t)mr * NADA + chunk * DM; const float* scp = shp + DM;
#pragma unroll
        for (int j = 0; j < 8; ++j) { const int c = 4 * lane + 256 * j; gs[j] = *(const f32x4*)(g + c) * (*(const f32x4*)(scp + c) + 1.0f); sh[j] = *(const f32x4*)(shp + c); }
        load_row(v, xs32 ? xs32 + (size_t)s * DM : nullptr, xb + (size_t)(MP + s) * DM, lane);
        if (fx.S) sample_fix(v, fx, s, xb + (size_t)(MP + s) * DM, lane);
        norm_row<FGATE>(v, H + (size_t)(MP + s) * DM, gs, sh, lane, wfA, wfB, bf, FGATE ? out + OFF_BFS + (size_t)s * 8 : nullptr);
    }
}
__device__ __forceinline__ void final_norm_phase(bf16_t* xb, float* y, const float* g, const SampleFix fx, int G, int wg, int wave, int lane) {
    f32x4 gv[8], v[8], v2[8];
#pragma unroll
    for (int j = 0; j < 8; ++j) gv[j] = *(const f32x4*)(g + 4 * lane + 256 * j);
#define FN_ROW(V, ROW) do { float ss = 0.f; _Pragma("unroll") for (int j = 0; j < 8; ++j) ss += (V[j][0] * V[j][0] + V[j][1] * V[j][1]) + (V[j][2] * V[j][2] + V[j][3] * V[j][3]); \
        const float rstd = 1.0f / sqrtf(wave_sum(ss) * (1.0f / DM) + EPS); float* yr = y + (size_t)(ROW) * DM; \
        _Pragma("unroll") for (int j = 0; j < 8; ++j) __builtin_nontemporal_store(V[j] * rstd * gv[j], (f32x4*)(yr + 4 * lane + 256 * j)); } while (0)
    for (int row = (wg * 8 + wave) * 2; row < MP; row += G * 16) {
        load_row(v, nullptr, xb + (size_t)row * DM, lane); load_row(v2, nullptr, xb + (size_t)(row + 1) * DM, lane);
        FN_ROW(v, row); FN_ROW(v2, row + 1);
    }
    for (int s = wave * G + wg; s < MS; s += 8 * G) {
        load_row(v, nullptr, xb + (size_t)(MP + s) * DM, lane);
        if (fx.S) sample_fix(v, fx, s, xb + (size_t)(MP + s) * DM, lane);
        FN_ROW(v, MP + s);
    }
#undef FN_ROW
}

__device__ __forceinline__ void cumsum_seq(const float* s1, int n1, const float* s2, int n2, float* dst, LAS unsigned char* lds, int tid, int wave, int lane) {
    LAS double* red = (LAS double*)lds;
    const int n = n1 + n2;
    double loc[9]; double run = 0.0;
#pragma unroll
    for (int e = 0; e < 9; ++e) { const int pos = 9 * tid + e; float v = 0.f;
        if (pos < n) v = (pos < n1) ? s1[(size_t)pos * 8] : s2[(size_t)(pos - n1) * 8];
        run += (double)v; loc[e] = run; }
    double x = run;
#pragma unroll
    for (int o = 1; o < 64; o <<= 1) { const double y = __shfl_up(x, o); if (lane >= o) x += y; }
    __syncthreads();
    if (lane == 63) red[wave] = x;
    __syncthreads();
    double pre = x - run;
    for (int w = 0; w < wave; ++w) pre += red[w];
#pragma unroll
    for (int e = 0; e < 9; ++e) { const int pos = 9 * tid + e; if (pos < n) dst[pos] = (float)((pre + loc[e]) * 1.4426950408889634); }
    __syncthreads();
}

namespace att {
constexpr int SHM = 16384;
constexpr int L_V = 0, L_K = 2 * SHM, L_WS = 4 * SHM, L_TAB = L_WS + 2048, L_FK = L_TAB + 1024, L_ACT = L_FK + 512, L_END = L_ACT + 64;
constexpr float THR2 = 11.0f;
#define KSWZ(row, colB) ((row) * 256 + ((colB) ^ (((row) & 7) << 4)))
__device__ __forceinline__ int v_st(int k, int c) { const int kk = (k & ~0xC) | ((k & 4) << 1) | ((k & 8) >> 1); return ((kk >> 3) * 4 + (c >> 5)) * 512 + ((kk & 7) * 32 + (c & 31)) * 2; }
__device__ __forceinline__ int v_rd_base(int lane) { return ((lane & 3) << 3) | (((lane >> 2) & 3) << 6) | (((lane >> 4) & 1) << 5) | (((lane >> 5) & 1) << 8); }
__device__ __forceinline__ int crow(int r, int hi) { return (r & 3) + 8 * (r >> 2) + 4 * hi; }

struct Args {
    const void* K1; const void* V1; const void* K2; const void* V2;
    const bf16_t* Q; bf16_t* O;
    const float* F;
    const float* tabsrc; int tabkind;
    float* o1s; const float* subg; float lam; float kmax2;
    int ks, qs, os, nrows, qpos0, kpos0, nt, tsplit, band;
};

template <int ND0, bool K128P = false>
__device__ __forceinline__ void qkt(f32x16& p0, f32x16& p1, const f32x16& c0, const f32x16& c1, const LAS unsigned char* Kt, int r32, int hi, const bf16x8 (&qr)[ND0]) {
    p0 = c0; p1 = c1;
    const LAS unsigned char* kb[4];
#pragma unroll
    for (int dd = 0; dd < 4; ++dd) kb[dd] = K128P ? Kt + r32 * 128 + (((dd * 2 + hi) ^ ((r32 >> 1) & 7)) << 4) : Kt + KSWZ(r32, (dd * 16 + hi * 8) * 2);
#pragma unroll
    for (int d0 = 0; d0 < ND0; ++d0) { const LAS unsigned char* a = kb[d0 & 3] + (d0 >> 2) * 128;
        const bf16x8 b0 = *(const LAS bf16x8*)a;
        const bf16x8 b1 = *(const LAS bf16x8*)(a + 32 * (K128P ? 128 : 256));
        p0 = __builtin_amdgcn_mfma_f32_32x32x16_bf16(b0, qr[d0], p0, 0, 0, 0);
        p1 = __builtin_amdgcn_mfma_f32_32x32x16_bf16(b1, qr[d0], p1, 0, 0, 0); }
}
#define TRRD(p) __builtin_amdgcn_ds_read_tr16_b64_v4i16((LAS s16x4*)(p))
__device__ __forceinline__ void pv_tile(f32x16 (&o)[4], const LAS unsigned char* vb, bf16x8 pa0, bf16x8 pa1, bf16x8 pa2, bf16x8 pa3) {
    s16x4 la[4], ha[4], lb[4], hb[4];
#define PV_RD(L, H, ks) _Pragma("unroll") for (int d0 = 0; d0 < 4; ++d0) { L[d0] = TRRD(vb + d0 * 512 + (ks) * 4096); H[d0] = TRRD(vb + d0 * 512 + (ks) * 4096 + 2048); }
#define PV_MM(L, H, pa) _Pragma("unroll") for (int d0 = 0; d0 < 4; ++d0) o[d0] = __builtin_amdgcn_mfma_f32_32x32x16_bf16((bf16x8){L[d0][0], L[d0][1], L[d0][2], L[d0][3], H[d0][0], H[d0][1], H[d0][2], H[d0][3]}, pa, o[d0], 0, 0, 0);
    PV_RD(la, ha, 0) SBAR();
    PV_RD(lb, hb, 1) PV_MM(la, ha, pa0) SBAR();
    PV_RD(la, ha, 2) PV_MM(lb, hb, pa1) SBAR();
    PV_RD(lb, hb, 3) PV_MM(la, ha, pa2) SBAR();
    PV_MM(lb, hb, pa3) SBAR();
#undef PV_RD
#undef PV_MM
}
__device__ __forceinline__ int t5_bucket(int rel) {
    const int n = rel < 0 ? -rel : rel; int b;
    if (n < 8) b = n; else if (n < 12) b = 8; else if (n < 16) b = 9; else if (n < 23) b = 10; else if (n < 32) b = 11; else if (n < 46) b = 12; else if (n < 64) b = 13; else if (n < 91) b = 14; else b = 15;
    return b + (rel > 0 ? 16 : 0);
}

template <bool F32SRC, int DQK, int MODE, bool PRUNE = false>
__device__ __forceinline__ void attn_item(LAS unsigned char* lds, const Args& a, int wave_s) {
    constexpr bool DUAL = F32SRC && DQK == 64;
    constexpr int ND0 = DQK / 16, NPASS = (DQK == 64 && !DUAL) ? 2 : 1;
    constexpr bool KHALF = !F32SRC && DQK == 64;
    const int tid = fresh_tid(wave_s), wave = __builtin_amdgcn_readfirstlane(tid >> 6), lane = tid & 63, r32 = lane & 31, hi = lane >> 5;
    LAS unsigned char* V_lds = lds + L_V; LAS unsigned char* K_lds = lds + L_K;
    LAS float* li_l = (LAS float*)(lds + L_WS) + wave * 64; LAS float* al_l = li_l + 32;
    LAS float* tab = (LAS float*)(lds + L_TAB); LAS float* fk = (LAS float*)(lds + L_FK);
    const int rg = DUAL ? (wave & 1) : wave, hfw = DUAL ? (wave >> 1) : 0;
    const bool wact = DUAL ? (wave < 4) : (wave * 32 < a.nrows);
    const int wq0 = a.qpos0 + rg * 32, cq = wq0 >> 6, qpos = wq0 + r32;
    const int sr = tid >> 4, sc = (tid & 15) * 8;
    const int kws = KSWZ(sr, sc * 2), vst0 = v_st(sr, sc), vst1 = v_st(32 + sr, sc);
    const LAS unsigned char* vb = V_lds + v_rd_base(lane);
    bf16x8 sk0, sk1, sv0, sv1; f32x4 fk0a, fk0b, fk1a, fk1b, fv0a, fv0b, fv1a, fv1b; float ff = 0.f;
    int vdo[2] = {0, 0}, kdo = 0;
    if constexpr (KHALF) {
#pragma unroll
        for (int j = 0; j < 2; ++j) { const int P = (wave * 2 + j) * 64 + lane; const int kk = ((P >> 7) << 3) | ((P >> 2) & 7), kr = (kk & ~0xC) | ((kk & 4) << 1) | ((kk & 8) >> 1), c = ((P >> 5) & 3) * 32 + (P & 3) * 8; vdo[j] = kr * a.ks + c; }
        { const int P = wave * 64 + lane, r = P >> 3, c = (P & 7) ^ ((r >> 1) & 7); kdo = r * a.ks + c * 8; }
    }
#define AT_LOAD(t) do { const int t_ = (t); const bool s2_ = t_ >= a.tsplit; const size_t ro_ = (size_t)((s2_ ? t_ - a.tsplit : t_) * 64 + sr) * a.ks + sc; const size_t r32o_ = (size_t)32 * a.ks; \
        if constexpr (F32SRC) { const float* kp_ = (const float*)(s2_ ? a.K2 : a.K1) + ro_; const float* vp_ = (const float*)(s2_ ? a.V2 : a.V1) + ro_; \
            fv0a = *(const f32x4*)vp_; fv0b = *(const f32x4*)(vp_ + 4); fv1a = *(const f32x4*)(vp_ + r32o_); fv1b = *(const f32x4*)(vp_ + r32o_ + 4); \
            fk0a = *(const f32x4*)kp_; fk0b = *(const f32x4*)(kp_ + 4); fk1a = *(const f32x4*)(kp_ + r32o_); fk1b = *(const f32x4*)(kp_ + r32o_ + 4); } \
        else if constexpr (KHALF) { } \
        else { const bf16_t* kp_ = (const bf16_t*)(s2_ ? a.K2 : a.K1) + ro_; const bf16_t* vp_ = (const bf16_t*)(s2_ ? a.V2 : a.V1) + ro_; \
            sv0 = *(const bf16x8*)vp_; sv1 = *(const bf16x8*)(vp_ + r32o_); sk0 = *(const bf16x8*)kp_; sk1 = *(const bf16x8*)(kp_ + r32o_); } \
        if constexpr (MODE == 1) { if (tid < 64) ff = a.F[t_ * 64 + tid]; } } while (0)
#define AT_VDMA(t, bf) do { if constexpr (KHALF) { const int t_ = (t); const bool s2_ = t_ >= a.tsplit; const bf16_t* vb_ = (const bf16_t*)(s2_ ? a.V2 : a.V1) + (size_t)((s2_ ? t_ - a.tsplit : t_) * 64) * a.ks; \
        _Pragma("unroll") for (int j_ = 0; j_ < 2; ++j_) __builtin_amdgcn_global_load_lds((const unsigned*)(vb_ + vdo[j_]), (LAS unsigned*)(V_lds + (bf) * SHM + (wave * 2 + j_) * 1024), 16, 0, 0); \
        const bf16_t* kb_ = (const bf16_t*)(s2_ ? a.K2 : a.K1) + (size_t)((s2_ ? t_ - a.tsplit : t_) * 64) * a.ks + pass * 64; \
        __builtin_amdgcn_global_load_lds((const unsigned*)(kb_ + kdo), (LAS unsigned*)(K_lds + (bf) * SHM + wave * 1024), 16, 0, 0); } } while (0)
#define AT_WRITE(bf) do { const int b_ = (bf); \
        if constexpr (F32SRC) { sk0 = pack8(fk0a, fk0b); sk1 = pack8(fk1a, fk1b); sv0 = pack8(fv0a, fv0b); sv1 = pack8(fv1a, fv1b); } \
        if constexpr (KHALF) { } \
        else { *(LAS bf16x8*)(K_lds + b_ * SHM + kws) = sk0; *(LAS bf16x8*)(K_lds + b_ * SHM + kws + 32 * 256) = sk1; } \
        if constexpr (!KHALF) { *(LAS bf16x8*)(V_lds + b_ * SHM + vst0) = sv0; *(LAS bf16x8*)(V_lds + b_ * SHM + vst1) = sv1; } \
        if constexpr (MODE == 1) { if (tid < 64) fk[b_ * 64 + tid] = -ff; } } while (0)

    for (int pass = 0; pass < NPASS; ++pass) {
        bf16x8 qr[ND0];
#pragma unroll
        for (int d0 = 0; d0 < ND0; ++d0) qr[d0] = wact ? *(const bf16x8*)(a.Q + (size_t)(rg * 32 + r32) * a.qs + (DUAL ? hfw : pass) * 64 + d0 * 16 + hi * 8) : bf16x8{};
        float m_reg = -1e30f, l_reg = 0.f; f32x16 o[4];
#pragma unroll
        for (int d0 = 0; d0 < 4; ++d0) o[d0] = f32x16{};
        f32x16 cfar = f32x16{}; bool cdirty = true;
        float sbound = 0.f; bool wdone = false;
        if constexpr (PRUNE) {
            float qq = 0.f;
#pragma unroll
            for (int d0 = 0; d0 < ND0; ++d0)
#pragma unroll
                for (int e = 0; e < 8; ++e) { const float x = __uint_as_float(((unsigned)(unsigned short)qr[d0][e]) << 16); qq += x * x; }
            { auto rr = __builtin_amdgcn_permlane32_swap(__float_as_uint(qq), __float_as_uint(qq), false, false); qq = __uint_as_float(rr[0]) + __uint_as_float(rr[1]); }
#pragma unroll
            for (int x = 1; x < 32; x <<= 1) qq = fmaxf(qq, __shfl_xor(qq, x));
            sbound = sqrtf(qq * a.kmax2) * 1.02f + 0.5f;
            LAS int* actf = (LAS int*)(lds + L_ACT);
            if (tid < 16) actf[tid] = 0;
        }
#define AT_TILE(i_) (PRUNE ? (a.nt - 1 - (i_)) : (i_))
        AT_LOAD(AT_TILE(0)); AT_VDMA(AT_TILE(0), 0);
        if constexpr (MODE == 0) {
            if (pass == 0 && tid < 256) { int rel = tid - 192; if (rel < -128) rel = -128; float v;
                if (a.tabkind == 0) v = a.tabsrc[t5_bucket(rel) * 8]; else v = a.tabsrc[(rel + 128) * 16];
                tab[tid] = v * LOG2E; }
        }
        AT_WRITE(0);
        __syncthreads();
        if (wave >= 4) __builtin_amdgcn_s_setprio(1);
        for (int it = 0; it < a.nt; ++it) {
            const int buf = it & 1, t = AT_TILE(it);
            if (it + 1 < a.nt) { AT_LOAD(AT_TILE(it + 1)); AT_VDMA(AT_TILE(it + 1), buf ^ 1); }
            SBAR();
            const int kb = a.kpos0 + 64 * t;
            bool act;
            if constexpr (MODE == 0) { const int kc = kb >> 6; act = wact && (kc <= cq) && (kc >= cq - a.band); }
            else act = wact && (kb <= wq0 + 31);
            if constexpr (PRUNE) {
                if (act && !wdone) {
                    float mm = m_reg;
#pragma unroll
                    for (int x = 1; x < 32; x <<= 1) mm = fminf(mm, __shfl_xor(mm, x));
                    const float btile = fk[buf * 64 + 63];
                    if (__all(mm > -1e29f && sbound + btile - mm < -40.0f)) wdone = true;
                }
                act = act && !wdone;
            }
            if (act) {
                f32x16 p0, p1; float alpha = 1.f, ps = 0.f;
                if constexpr (F32SRC) {
                                { const f32x16 z = f32x16{}; qkt<ND0>(p0, p1, z, z, K_lds + buf * SHM + (DUAL ? hfw : pass) * 128, r32, hi, qr); }
                float cb = 0.f;
                if constexpr (MODE == 0) {
                    if (kb - wq0 + 191 <= 0) cb = tab[0];
                    else { const LAS float* tp = tab + (kb - qpos + 4 * hi + 192);
#pragma unroll
                        for (int r = 0; r < 16; ++r) { const int c = (r & 3) + 8 * (r >> 2); p0[r] += tp[c]; p1[r] += tp[c + 32]; } }
                } else {
                    const LAS f32x4* f4 = (const LAS f32x4*)(fk + buf * 64);
#pragma unroll
                    for (int j = 0; j < 4; ++j) { const f32x4 fa = f4[2 * j + hi], fb = f4[8 + 2 * j + hi];
#pragma unroll
                        for (int e = 0; e < 4; ++e) { p0[4 * j + e] += fa[e]; p1[4 * j + e] += fb[e]; } }
                    if (kb + 63 > wq0) { const int dq = qpos - kb - 4 * hi; const float NEG = -__builtin_inff();
#pragma unroll
                        for (int r = 0; r < 16; ++r) { const int c = (r & 3) + 8 * (r >> 2); if (c > dq) p0[r] = NEG; if (c + 32 > dq) p1[r] = NEG; } }
                }
                float pmax = p0[0];
#pragma unroll
                for (int r = 1; r < 16; ++r) pmax = fmaxf(pmax, p0[r]);
#pragma unroll
                for (int r = 0; r < 16; ++r) pmax = fmaxf(pmax, p1[r]);
                { auto rr = __builtin_amdgcn_permlane32_swap(__float_as_uint(pmax), __float_as_uint(pmax), false, false);
                  pmax = fmaxf(__uint_as_float(rr[0]), __uint_as_float(rr[1])) + cb; }
                float mn;
                if (__all((pmax - m_reg) <= THR2)) { mn = m_reg; }
                else { mn = fmaxf(m_reg, pmax); alpha = __builtin_amdgcn_exp2f(m_reg - mn); m_reg = mn; }
                const float mnc = mn - cb;
#pragma unroll
                for (int r = 0; r < 16; ++r) { p0[r] = __builtin_amdgcn_exp2f(p0[r] - mnc); p1[r] = __builtin_amdgcn_exp2f(p1[r] - mnc); ps += p0[r] + p1[r]; }
                { auto rr = __builtin_amdgcn_permlane32_swap(__float_as_uint(ps), __float_as_uint(ps), false, false);
                  ps = __uint_as_float(rr[0]) + __uint_as_float(rr[1]); }
                } else {
                const bool fl = m_reg < -1e29f; const float mref = fl ? 0.f : m_reg;
#define AT_BIAS(D0, D1, OP) do { \
                if constexpr (MODE == 0) { \
                    if (kb - wq0 + 191 <= 0) { const float nb = tab[0] - mref; \
                        _Pragma("unroll") for (int r = 0; r < 16; ++r) { D0[r] OP nb; D1[r] OP nb; } } \
                    else { const LAS float* tp = tab + (kb - qpos + 4 * hi + 192); \
                        _Pragma("unroll") for (int r = 0; r < 16; ++r) { const int c = (r & 3) + 8 * (r >> 2); D0[r] OP tp[c] - mref; D1[r] OP tp[c + 32] - mref; } } \
                } else { \
                    const LAS f32x4* f4 = (const LAS f32x4*)(fk + buf * 64); \
                    _Pragma("unroll") for (int j = 0; j < 4; ++j) { const f32x4 fa = f4[2 * j + hi], fb = f4[8 + 2 * j + hi]; \
                        _Pragma("unroll") for (int e = 0; e < 4; ++e) { D0[4 * j + e] OP fa[e] - mref; D1[4 * j + e] OP fb[e] - mref; } } \
                } } while (0)
                if (MODE == 0 && kb - wq0 + 191 <= 0) {
                    if constexpr (KHALF) {
                        if (cdirty) { const float nb = tab[0] - mref;
#pragma unroll
                            for (int r = 0; r < 16; ++r) cfar[r] = nb;
                            cdirty = false; }
                        qkt<ND0, KHALF>(p0, p1, cfar, cfar, K_lds + buf * SHM, r32, hi, qr);
                    } else {
                    f32x16 c; const float nb = tab[0] - mref;
#pragma unroll
                    for (int r = 0; r < 16; ++r) c[r] = nb;
                    qkt<ND0, KHALF>(p0, p1, c, c, K_lds + buf * SHM + (KHALF ? 0 : (DUAL ? hfw : pass) * 128), r32, hi, qr); }
                } else { f32x16 c0, c1; AT_BIAS(c0, c1, =); qkt<ND0, KHALF>(p0, p1, c0, c1, K_lds + buf * SHM + (KHALF ? 0 : (DUAL ? hfw : pass) * 128), r32, hi, qr); }
#undef AT_BIAS
                if constexpr (MODE == 1) {
                    if (kb + 63 > wq0) { const int dq = qpos - kb - 4 * hi; const float NEG = -__builtin_inff();
#pragma unroll
                        for (int r = 0; r < 16; ++r) { const int c = (r & 3) + 8 * (r >> 2); if (c > dq) p0[r] = NEG; if (c + 32 > dq) p1[r] = NEG; } }
                }
                float pmax = p0[0];
#pragma unroll
                for (int r = 1; r < 16; ++r) pmax = fmaxf(pmax, p0[r]);
#pragma unroll
                for (int r = 0; r < 16; ++r) pmax = fmaxf(pmax, p1[r]);
                { auto rr = __builtin_amdgcn_permlane32_swap(__float_as_uint(pmax), __float_as_uint(pmax), false, false);
                  pmax = fmaxf(__uint_as_float(rr[0]), __uint_as_float(rr[1])); }
                float d = 0.f;
                const bool common = __all(!fl && pmax <= THR2);
                if (!common) { d = fl ? fmaxf(pmax, -1e30f) : fmaxf(pmax, 0.f); alpha = fl ? 1.f : __builtin_amdgcn_exp2f(-d); m_reg = mref + d; cdirty = true; }
                if (common) {
#pragma unroll
                    for (int r = 0; r < 16; ++r) { p0[r] = __builtin_amdgcn_exp2f(p0[r]); p1[r] = __builtin_amdgcn_exp2f(p1[r]); ps += p0[r] + p1[r]; }
                } else {
#pragma unroll
                    for (int r = 0; r < 16; ++r) { p0[r] = __builtin_amdgcn_exp2f(p0[r] - d); p1[r] = __builtin_amdgcn_exp2f(p1[r] - d); ps += p0[r] + p1[r]; }
                }
                { auto rr = __builtin_amdgcn_permlane32_swap(__float_as_uint(ps), __float_as_uint(ps), false, false);
                  ps = __uint_as_float(rr[0]) + __uint_as_float(rr[1]); }
                }
                l_reg = l_reg * alpha + ps;
                bf16x8 pa0, pa1, pa2, pa3;
#define PK4(P, B_, OUT) do { unsigned a0 = cvtpk(P[B_+0], P[B_+1]), a1 = cvtpk(P[B_+2], P[B_+3]); \
        unsigned b0 = cvtpk(P[B_+4], P[B_+5]), b1 = cvtpk(P[B_+6], P[B_+7]); \
        auto r0 = __builtin_amdgcn_permlane32_swap(a0, b0, false, false); auto r1 = __builtin_amdgcn_permlane32_swap(a1, b1, false, false); \
        u32x4 w = {r0[0], r1[0], r0[1], r1[1]}; OUT = *reinterpret_cast<bf16x8*>(&w); } while (0)
                PK4(p0, 0, pa0); PK4(p0, 8, pa1); PK4(p1, 0, pa2); PK4(p1, 8, pa3);
#undef PK4
                if (__any(alpha < 1.f)) {
#pragma unroll
                    for (int d0 = 0; d0 < 4; ++d0)
#pragma unroll
                        for (int r = 0; r < 16; ++r) o[d0][r] *= alpha; }
                pv_tile(o, vb + buf * SHM, pa0, pa1, pa2, pa3);
            }
            SBAR();
            if (it + 1 < a.nt) AT_WRITE(buf ^ 1);
            if constexpr (PRUNE) { if (lane == 0) ((LAS int*)(lds + L_ACT))[buf * 8 + wave] = (wact && !wdone) ? 1 : 0; }
            __syncthreads();
            if constexpr (PRUNE) { const LAS int* af = (const LAS int*)(lds + L_ACT) + buf * 8; int any = 0;
#pragma unroll
                for (int w = 0; w < 8; ++w) any |= af[w];
                if (!any) break; }
        }
#undef AT_TILE
        __builtin_amdgcn_s_setprio(0);
        const float rl = __builtin_amdgcn_rcpf(l_reg);
#define AT_STORE_ROW(OROW, VAL) do { _Pragma("unroll") for (int d0 = 0; d0 < 4; ++d0) _Pragma("unroll") for (int k = 0; k < 2; ++k) { \
            unsigned x0 = cvtpk(VAL(d0, 8 * k + 0), VAL(d0, 8 * k + 1)), x1 = cvtpk(VAL(d0, 8 * k + 2), VAL(d0, 8 * k + 3)); \
            unsigned y0 = cvtpk(VAL(d0, 8 * k + 4), VAL(d0, 8 * k + 5)), y1 = cvtpk(VAL(d0, 8 * k + 6), VAL(d0, 8 * k + 7)); \
            auto s0 = __builtin_amdgcn_permlane32_swap(x0, y0, false, false); auto s1 = __builtin_amdgcn_permlane32_swap(x1, y1, false, false); \
            u32x4 w = {s0[0], s1[0], s0[1], s1[1]}; \
            int oo = d0 * 32 + 16 * k + 8 * hi; asm volatile("" : "+v"(oo)); \
            *(u32x4*)((OROW) + oo) = w; } } while (0)
        if constexpr (DUAL) {
            LAS float* X = (LAS float*)(lds + 73728);
            if (wact && hfw == 1) {
#pragma unroll
                for (int r = 0; r < 16; ++r)
#pragma unroll
                    for (int d0 = 0; d0 < 4; ++d0) X[(rg * 64 + r * 4 + d0) * 64 + lane] = o[d0][r] * rl;
            }
            __syncthreads();
            if (wact && hfw == 0) {
                float ssq = 0.f;
#pragma unroll
                for (int r = 0; r < 16; ++r)
#pragma unroll
                    for (int d0 = 0; d0 < 4; ++d0) { const float v = o[d0][r] * rl - a.lam * X[(rg * 64 + r * 4 + d0) * 64 + lane]; o[d0][r] = v; ssq += v * v; }
                { auto rr = __builtin_amdgcn_permlane32_swap(__float_as_uint(ssq), __float_as_uint(ssq), false, false); ssq = __uint_as_float(rr[0]) + __uint_as_float(rr[1]); }
                const float rs = 0.8f * __builtin_amdgcn_rsqf(ssq * (1.0f / 128.0f) + EPS);
                bf16_t* orow = a.O + (size_t)(rg * 32 + r32) * a.os;
                const float* gp = a.subg + 4 * hi;
#pragma unroll
                for (int d0 = 0; d0 < 4; ++d0)
#pragma unroll
                    for (int g = 0; g < 4; ++g) { const f32x4 gg = *(const f32x4*)(gp + d0 * 32 + 8 * g);
#pragma unroll
                        for (int e = 0; e < 4; ++e) o[d0][4 * g + e] *= rs * gg[e]; }
#define AT_VAL(d0_, r_) o[d0_][r_]
                AT_STORE_ROW(orow, AT_VAL);
#undef AT_VAL
            }
        } else
        if (wact) {
            if (DQK == 64 && pass == 0) {
#pragma unroll
                for (int r = 0; r < 16; ++r) {
                    int so = wave * 4096 + r * 256 + lane; asm volatile("" : "+v"(so));
                    float* sp = a.o1s + so;
#pragma unroll
                    for (int d0 = 0; d0 < 4; ++d0) sp[d0 * 64] = o[d0][r] * rl; }
                VM_WAIT();
            } else {
                bf16_t* orow = a.O + (size_t)(wave * 32 + r32) * a.os;
                if constexpr (DQK == 64) {
                    float ssq = 0.f;
#pragma unroll
                    for (int r = 0; r < 16; ++r) {
                        int so = wave * 4096 + r * 256 + lane; asm volatile("" : "+v"(so));
                        const float* sp = a.o1s + so;
#pragma unroll
                        for (int d0 = 0; d0 < 4; ++d0) { const float o1 = __hip_atomic_load(sp + d0 * 64, __ATOMIC_RELAXED, __HIP_MEMORY_SCOPE_AGENT);
                            const float v = o1 - a.lam * (o[d0][r] * rl); o[d0][r] = v; ssq += v * v; } }
                    { auto rr = __builtin_amdgcn_permlane32_swap(__float_as_uint(ssq), __float_as_uint(ssq), false, false); ssq = __uint_as_float(rr[0]) + __uint_as_float(rr[1]); }
                    const float rs = 0.8f * __builtin_amdgcn_rsqf(ssq * (1.0f / 128.0f) + EPS);
                    const float* gp = a.subg + 4 * hi;
#pragma unroll
                    for (int d0 = 0; d0 < 4; ++d0)
#pragma unroll
                        for (int g = 0; g < 4; ++g) { const f32x4 gg = *(const f32x4*)(gp + d0 * 32 + 8 * g);
#pragma unroll
                            for (int e = 0; e < 4; ++e) o[d0][4 * g + e] *= rs * gg[e]; }
                } else {
#pragma unroll
                    for (int d0 = 0; d0 < 4; ++d0)
#pragma unroll
                        for (int r = 0; r < 16; ++r) o[d0][r] *= rl;
                }
#define AT_VAL(d0_, r_) o[d0_][r_]
                AT_STORE_ROW(orow, AT_VAL);
#undef AT_VAL
            }
        }
#undef AT_STORE_ROW
        __syncthreads();
    }
#undef AT_LOAD
#undef AT_WRITE
#undef AT_VDMA
}
}

struct KArgs { InPtrs in; float* out; unsigned char* ws; int ph_lo, ph_hi; };

#define Q_PRE() unsigned nx_ = 0u; if (tid == 0) nx_ = __hip_atomic_fetch_add(qw, 1u, __ATOMIC_RELAXED, __HIP_MEMORY_SCOPE_AGENT)
__device__ __forceinline__ int q_post(unsigned nx, volatile LAS unsigned* slot, int tid) {
    if (tid == 0) *slot = nx;
    __syncthreads();
    return (int)*slot;
}
__device__ __forceinline__ int q_next(unsigned* qw, volatile LAS unsigned* slot, int tid) {
    __syncthreads();
    if (tid == 0) *slot = __hip_atomic_fetch_add(qw, 1u, __ATOMIC_RELAXED, __HIP_MEMORY_SCOPE_AGENT);
    __syncthreads();
    return (int)*slot;
}

__device__ __forceinline__ void sample_qkv_finalize(const float* part, int b, int colq, int colk, int colv, float qscale, bf16_t* BIG, float* outK, float* outV, int ldf, int hcol, int tid) {
    for (int i = tid; i < 3 * 64 * 16; i += 512) {
        const int sec3 = i >> 10, r = (i & 1023) >> 4, c8 = (i & 15) * 8;
        const int col = (sec3 == 0 ? colq : (sec3 == 1 ? colk : colv)) + c8;
        const float* pp = part + ((size_t)(b * 64 + r)) * NQKV + col;
        f32x4 s0 = {0.f, 0.f, 0.f, 0.f}, s1 = {0.f, 0.f, 0.f, 0.f};
#pragma unroll
        for (int sl = 0; sl < 5; ++sl) { s0 += *(const f32x4*)(pp + (size_t)sl * MS * NQKV); s1 += *(const f32x4*)(pp + (size_t)sl * MS * NQKV + 4); }
        if (sec3 == 1) { float* d = outK + (size_t)(b * 64 + r) * ldf + hcol + c8; *(f32x4*)d = s0; *(f32x4*)(d + 4) = s1; }
        if (sec3 == 2) { float* d = outV + (size_t)(b * 64 + r) * ldf + hcol + c8; *(f32x4*)d = s0; *(f32x4*)(d + 4) = s1; }
        const float sc = sec3 == 0 ? qscale : 1.0f;
        u32x4 w; w.x = cvtpk(s0[0] * sc, s0[1] * sc); w.y = cvtpk(s0[2] * sc, s0[3] * sc); w.z = cvtpk(s1[0] * sc, s1[1] * sc); w.w = cvtpk(s1[2] * sc, s1[3] * sc);
        *(u32x4*)(BIG + (size_t)(MP + b * 64 + r) * NQKV + col) = w;
    }
    VM_WAIT(); __syncthreads();
}

template <int l>
__device__ __forceinline__ void layer_phases(LAS unsigned char* lds, unsigned char* ws, float* out, unsigned* ctl, const XcdBarrier& bar, int G, int wg, int wave0, int lo, int hi_, int& phase) {
    volatile LAS unsigned* MISC = (volatile LAS unsigned*)(lds + MISC_OFF);
    bf16_t* H = (bf16_t*)(ws + WS_H); bf16_t* BIG = (bf16_t*)(ws + WS_BIG); bf16_t* ATT = (bf16_t*)(ws + WS_ATT); bf16_t* XB = (bf16_t*)(ws + WS_XB);
    float* mods = (float*)(ws + WS_MODS);
#define PH_BEGIN if (phase >= lo && phase < hi_) { const int tid = fresh_tid(wave0), lane = tid & 63, wave = __builtin_amdgcn_readfirstlane(tid >> 6); (void)lane; (void)wave;
#define PH_END   if (MK_N_LAUNCHES == 1) xcd_barrier(bar, fresh_tid(wave0)); } ++phase;
#define MODS_L (mods + (size_t)l * 16 * NADA)
#define NG_L (inp(lds, 13) + (size_t)l * 3 * DM)
        PH_BEGIN { if (EN(2)) { norm_phase<false>((l == 0) ? inp(lds, 0) : nullptr, (l == 0) ? inp(lds, 1) : nullptr, XB, NG_L, MODS_L, 0, H, nullptr, nullptr, out, SampleFix{(const float*)(ws + WS_PART), (l == 0) ? 0 : 15, mods + 8 * DM, 0.5f}, lds, G, wg, tid, wave, lane); } } PH_END
        PH_BEGIN { pg8::Gemm g{H, (const bf16_t*)(ws + WS_WFI + (size_t)(l * 2 + 0) * SZ_WFI), MROWS, 11008, DM}; pg8::StaticOrder S; S.init(MROWS, 11008, G, wg); S.ntk = DM / 64;
            EpiSwiGLU E{BIG}; { if (EN(6)) { pg8::gemm_phase<EpiSwiGLU, pg8::StaticOrder, true, true>(lds, g, S, E, wave0); } } } PH_END
        PH_BEGIN { pg8::Gemm g{BIG, (const bf16_t*)(ws + WS_WFO + (size_t)(l * 2 + 0) * SZ_WFO), MROWS, DM, DFF}; pg8::SplitOrder S; S.init(DFF, DM, 15, G, wg);
            EpiResGate E{(l == 0) ? inp(lds, 0) : nullptr, XB, MODS_L + 2 * DM, 0.5f, (float*)(ws + WS_PART)}; { if (EN(7)) { pg8::gemm_phase<EpiResGate, pg8::SplitOrder, true, true>(lds, g, S, E, wave0); } } } PH_END
        PH_BEGIN if (l == 0) { if (EN(3)) { norm_phase<true>(nullptr, inp(lds, 1), XB, NG_L + DM, MODS_L, 3, H, inp(lds, 16), inp(lds, 17), out, SampleFix{(const float*)(ws + WS_PART), 15, MODS_L + 2 * DM, 0.5f}, lds, G, wg, tid, wave, lane); } }
                 else { if (EN(2)) { norm_phase<false>(nullptr, nullptr, XB, NG_L + DM, MODS_L, 3, H, nullptr, nullptr, out, SampleFix{(const float*)(ws + WS_PART), 15, MODS_L + 2 * DM, 0.5f}, lds, G, wg, tid, wave, lane); } } PH_END
        PH_BEGIN {
            if (l == 0 && wg < 128) {
                const int s = wg & 63, b = s >> 3, hh = s & 7;
                const bool smp = wg >= 64;
                const float* s1 = smp ? inp(lds, 6) + (size_t)b * PAST * 8 + hh : out + OFF_BFP + (size_t)b * SEQ * 8 + hh;
                const float* s2 = out + OFF_BFS + (size_t)b * DSEQ * 8 + hh;
                float* dst = smp ? (float*)(ws + WS_FS) + (size_t)s * (PAST + DSEQ) : (float*)(ws + WS_FP) + (size_t)s * SEQ;
                { if (EN(5)) { cumsum_seq(s1, SEQ, s2, smp ? DSEQ : 0, dst, lds, tid, wave, lane); } }
            }
            pg8::Gemm g{H, (const bf16_t*)(ws + (l == 0 ? WS_WINAB : WS_WINC)), MROWS, NQKV, DM}; pg8::SplitOrder S; S.init(DM, NQKV, 5, G, wg);
            EpiQKV E{BIG, out, l, (float*)(ws + WS_PART)};
            { if (EN(8)) { pg8::gemm_phase<EpiQKV, pg8::SplitOrder, true, true>(lds, g, S, E, wave0); } } } PH_END
        PH_BEGIN {
            att::Args a; a.o1s = (float*)(ws + WS_O1) + (size_t)wg * 32768; a.subg = inp(lds, 23); a.lam = 0.f; a.kmax2 = 0.f; a.F = nullptr; a.tabsrc = nullptr; a.tabkind = 0; a.band = 1 << 20;
            if (l == 0) {
                { float v1 = (lane < 64) ? inp(lds, 19)[lane] * inp(lds, 20)[lane] : 0.f, v2 = inp(lds, 21)[lane] * inp(lds, 22)[lane];
                  a.lam = expf(wave_sum(v1)) - expf(wave_sum(v2)) + 0.2f; }
                for (int u = wg; u < 256; u += G) {
                    const int s = u >> 2, b = s >> 3, h = s & 7;
                    const bf16_t* kp = BIG + (size_t)(b * SEQ + (u & 3) * 1024 + (tid >> 4)) * NQKV + 4096 + h * 128 + (tid & 15) * 8;
                    float mx = 0.f;
#pragma unroll 4
                    for (int i = 0; i < 32; ++i) { const bf16x8 v = *(const bf16x8*)(kp + (size_t)(32 * i) * NQKV); float ss = 0.f;
#pragma unroll
                        for (int e = 0; e < 8; ++e) { const float x = __uint_as_float(((unsigned)(unsigned short)v[e]) << 16); ss += x * x; }
                        ss += __shfl_xor(ss, 1); ss += __shfl_xor(ss, 2); ss += __shfl_xor(ss, 4); ss += __shfl_xor(ss, 8);
                        mx = fmaxf(mx, ss); }
                    mx = fmaxf(mx, __shfl_xor(mx, 16)); mx = fmaxf(mx, __shfl_xor(mx, 32));
                    if (lane == 0) __hip_atomic_fetch_max(ctl + CW_KMX + s, __float_as_uint(mx), __ATOMIC_RELAXED, __HIP_MEMORY_SCOPE_AGENT);
                }
                VM_WAIT(); __syncthreads();
                if (tid == 0) __hip_atomic_fetch_add(ctl + CW_KDONE, 1u, __ATOMIC_RELAXED, __HIP_MEMORY_SCOPE_AGENT);
                unsigned* qw = ctl + CW_Q0;
                int idx = q_next(qw, MISC + 12, tid);
                while (idx < 64) { Q_PRE(); const int b = idx >> 3, h = idx & 7;
                    a.K1 = inp(lds, 2) + ((size_t)b * PAST * 8 + h) * 128; a.V1 = inp(lds, 3) + ((size_t)b * PAST * 8 + h) * 128;
                    a.K2 = out + OFF_AKS + ((size_t)b * DSEQ * 8 + h) * 128; a.V2 = out + OFF_AVS + ((size_t)b * DSEQ * 8 + h) * 128; a.ks = 1024;
                    a.Q = BIG + (size_t)(MP + b * DSEQ) * NQKV + h * 128; a.qs = NQKV; a.O = ATT + (size_t)(MP + b * DSEQ) * DM + h * 128; a.os = DM;
                    a.nrows = 64; a.qpos0 = PAST; a.kpos0 = 0; a.nt = 65; a.tsplit = 64; a.tabsrc = inp(lds, 24) + h; a.tabkind = 0;
                    sample_qkv_finalize((const float*)(ws + WS_PART), b, h * 128, 1024 + h * 128, 2048 + h * 128, 1.0f, BIG, out + OFF_AKS, out + OFF_AVS, 1024, h * 128, tid);
                    { if (EN(9)) { att::attn_item<true, 64, 0>(lds, a, wave0); } } idx = q_post(nx_, MISC + 12 + (idx & 1), tid); }
                while (idx < 128) { Q_PRE(); const int s = idx - 64, b = s >> 3, h = s & 7;
                    a.K1 = inp(lds, 4) + ((size_t)b * PAST * 8 + h) * 128; a.V1 = inp(lds, 5) + ((size_t)b * PAST * 8 + h) * 128;
                    a.K2 = out + OFF_BKS + ((size_t)b * DSEQ * 8 + h) * 128; a.V2 = out + OFF_BVS + ((size_t)b * DSEQ * 8 + h) * 128; a.ks = 1024;
                    a.Q = BIG + (size_t)(MP + b * DSEQ) * NQKV + 3072 + h * 128; a.qs = NQKV; a.O = ATT + (size_t)(MP + b * DSEQ) * DM + 1024 + h * 128; a.os = DM;
                    a.nrows = 64; a.qpos0 = PAST; a.kpos0 = 0; a.nt = 65; a.tsplit = 64; a.F = (const float*)(ws + WS_FS) + (size_t)s * (PAST + DSEQ);
                    sample_qkv_finalize((const float*)(ws + WS_PART), b, 3072 + h * 128, 4096 + h * 128, 5120 + h * 128, 1.0f, BIG, out + OFF_BKS, out + OFF_BVS, 1024, h * 128, tid);
                    { if (EN(10)) { att::attn_item<true, 128, 1>(lds, a, wave0); } } idx = q_post(nx_, MISC + 12 + (idx & 1), tid); }
                while (idx < 128 + 1024) { Q_PRE(); const int p = idx - 128, j = 15 - (p >> 6), s = p & 63, b = s >> 3, h = s & 7;
                    const bf16_t* base = BIG + (size_t)(b * SEQ) * NQKV + h * 128;
                    a.K1 = base + 1024; a.V1 = base + 2048; a.K2 = a.K1; a.V2 = a.V1; a.ks = NQKV;
                    a.Q = base + (size_t)(256 * j) * NQKV; a.qs = NQKV; a.O = ATT + (size_t)(b * SEQ + 256 * j) * DM + h * 128; a.os = DM;
                    a.nrows = 256; a.qpos0 = 256 * j; a.kpos0 = 0; a.nt = 4 * (j + 1); a.tsplit = 1 << 20; a.tabsrc = inp(lds, 24) + h; a.tabkind = 0;
                    { if (EN(11)) { att::attn_item<false, 64, 0>(lds, a, wave0); } } idx = q_post(nx_, MISC + 12 + (idx & 1), tid); }
                if (idx < 128 + 2048) {
                    if (tid == 0) { unsigned sp = 0; while (__hip_atomic_load(ctl + CW_KDONE, __ATOMIC_RELAXED, __HIP_MEMORY_SCOPE_AGENT) < (unsigned)G) { __builtin_amdgcn_s_sleep(2); if (++sp > (1u << 22)) break; } }
                    __syncthreads();
                }
                while (idx < 128 + 2048) { Q_PRE(); const int p = idx - 128 - 1024, j = 15 - (p >> 6), s = p & 63, b = s >> 3, h = s & 7;
                    const bf16_t* base = BIG + (size_t)(b * SEQ) * NQKV + h * 128;
                    a.K1 = base + 4096; a.V1 = base + 5120; a.K2 = a.K1; a.V2 = a.V1; a.ks = NQKV;
                    a.Q = base + 3072 + (size_t)(256 * j) * NQKV; a.qs = NQKV; a.O = ATT + (size_t)(b * SEQ + 256 * j) * DM + 1024 + h * 128; a.os = DM;
                    a.nrows = 256; a.qpos0 = 256 * j; a.kpos0 = 0; a.nt = 4 * (j + 1); a.tsplit = 1 << 20; a.F = (const float*)(ws + WS_FP) + (size_t)s * SEQ;
                    a.kmax2 = __uint_as_float(__hip_atomic_load(ctl + CW_KMX + s, __ATOMIC_RELAXED, __HIP_MEMORY_SCOPE_AGENT));
                    { if (EN(12)) { att::attn_item<false, 128, 1, true>(lds, a, wave0); } } idx = q_post(nx_, MISC + 12 + (idx & 1), tid); }
            } else {
                unsigned* qw = ctl + CW_Q1;
                int idx = q_next(qw, MISC + 12, tid);
                a.band = 8; a.tabkind = 1;
                while (idx < 128) { Q_PRE(); const int b = idx >> 4, h = idx & 15;
                    a.K1 = inp(lds, 7) + ((size_t)b * 512 * 16 + h) * 128; a.V1 = inp(lds, 8) + ((size_t)b * 512 * 16 + h) * 128;
                    a.K2 = out + OFF_CKS + ((size_t)b * DSEQ * 16 + h) * 128; a.V2 = out + OFF_CVS + ((size_t)b * DSEQ * 16 + h) * 128; a.ks = 2048;
                    a.Q = BIG + (size_t)(MP + b * DSEQ) * NQKV + h * 128; a.qs = NQKV; a.O = ATT + (size_t)(MP + b * DSEQ) * DM + h * 128; a.os = DM;
                    a.nrows = 64; a.qpos0 = PAST; a.kpos0 = PAST - 512; a.nt = 9; a.tsplit = 8; a.tabsrc = inp(lds, 27) + h;
                    sample_qkv_finalize((const float*)(ws + WS_PART), b, h * 128, 2048 + h * 128, 4096 + h * 128, 1.0f, BIG, out + OFF_CKS, out + OFF_CVS, 2048, h * 128, tid);
                    { if (EN(13)) { att::attn_item<true, 128, 0>(lds, a, wave0); } } idx = q_post(nx_, MISC + 12 + (idx & 1), tid); }
                while (idx < 128 + 2048) { Q_PRE(); const int p = idx - 128, j = 15 - (p >> 7), s = p & 127, b = s >> 4, h = s & 15;
                    const int c0 = (4 * j - 8) > 0 ? (4 * j - 8) : 0;
                    const bf16_t* base = BIG + (size_t)(b * SEQ) * NQKV + h * 128;
                    a.K1 = base + 2048 + (size_t)(64 * c0) * NQKV; a.V1 = base + 4096 + (size_t)(64 * c0) * NQKV; a.K2 = a.K1; a.V2 = a.V1; a.ks = NQKV;
                    a.Q = base + (size_t)(256 * j) * NQKV; a.qs = NQKV; a.O = ATT + (size_t)(b * SEQ + 256 * j) * DM + h * 128; a.os = DM;
                    a.nrows = 256; a.qpos0 = 256 * j; a.kpos0 = 64 * c0; a.nt = 4 * j + 4 - c0; a.tsplit = 1 << 20; a.tabsrc = inp(lds, 27) + h;
                    { if (EN(14)) { att::attn_item<false, 128, 0>(lds, a, wave0); } } idx = q_post(nx_, MISC + 12 + (idx & 1), tid); }
            }
        } PH_END
        PH_BEGIN { pg8::Gemm g{ATT, (const bf16_t*)(ws + (l == 0 ? WS_WOUTAB : WS_WOUTC)), MROWS, DM, DM}; pg8::SplitOrder S; S.init(DM, DM, 8, G, wg);
            EpiResGate E{nullptr, XB, MODS_L + 5 * DM, 1.0f, (float*)(ws + WS_PART)}; { if (EN(7)) { pg8::gemm_phase<EpiResGate, pg8::SplitOrder, true, true>(lds, g, S, E, wave0); } } } PH_END
        PH_BEGIN { if (EN(2)) { norm_phase<false>(nullptr, nullptr, XB, NG_L + 2 * DM, MODS_L, 6, H, nullptr, nullptr, out, SampleFix{(const float*)(ws + WS_PART), 8, MODS_L + 5 * DM, 1.0f}, lds, G, wg, tid, wave, lane); } } PH_END
        PH_BEGIN { pg8::Gemm g{H, (const bf16_t*)(ws + WS_WFI + (size_t)(l * 2 + 1) * SZ_WFI), MROWS, 11008, DM}; pg8::StaticOrder S; S.init(MROWS, 11008, G, wg); S.ntk = DM / 64;
            EpiSwiGLU E{BIG}; { if (EN(6)) { pg8::gemm_phase<EpiSwiGLU, pg8::StaticOrder, true, true>(lds, g, S, E, wave0); } } } PH_END
        PH_BEGIN { pg8::Gemm g{BIG, (const bf16_t*)(ws + WS_WFO + (size_t)(l * 2 + 1) * SZ_WFO), MROWS, DM, DFF}; pg8::SplitOrder S; S.init(DFF, DM, 15, G, wg);
            EpiResGate E{nullptr, XB, MODS_L + 8 * DM, 0.5f, (float*)(ws + WS_PART)}; { if (EN(7)) { pg8::gemm_phase<EpiResGate, pg8::SplitOrder, true, true>(lds, g, S, E, wave0); } } } PH_END
#undef PH_BEGIN
#undef PH_END
}

__global__ void __launch_bounds__(512, 2) mega_fwd(KArgs args) {
    extern __shared__ __attribute__((aligned(16))) unsigned char lds_raw[];
    LAS unsigned char* lds = (LAS unsigned char*)lds_raw;
    volatile LAS unsigned* MISC = (volatile LAS unsigned*)(lds + MISC_OFF);
    const int tid0 = threadIdx.x;
    const int wave0 = __builtin_amdgcn_readfirstlane(tid0 >> 6);
    const int G = gridDim.x, wg = blockIdx.x;
    unsigned char* ws = args.ws; float* out = args.out;
    unsigned* ctl = (unsigned*)(ws + WS_CTL);
    for (int u = tid0; u < (LDS_BYTES - LDSCTL_OFF) / 4; u += 512) ((LAS unsigned*)(lds + LDSCTL_OFF))[u] = 0u;
    __syncthreads();
    if (tid0 == 0) {
#pragma unroll
        for (int i = 0; i < 29; ++i) ((LAS unsigned long long*)(lds + PTAB_OFF))[i] = (unsigned long long)args.in.p[i];
    }
    __syncthreads();
    XcdBarrier bar; bar.bar = ctl + CW_BAR; bar.x = 0; bar.st = nullptr;
    if (MK_N_LAUNCHES == 1) bar = xcd_barrier_post(ctl + CW_BAR, MISC + 8, tid0);
    const int lo = args.ph_lo, hi_ = args.ph_hi;
    int phase = 0;
#define PH_BEGIN if (phase >= lo && phase < hi_) { const int tid = fresh_tid(wave0), lane = tid & 63, wave = __builtin_amdgcn_readfirstlane(tid >> 6); (void)lane; (void)wave;
#define PH_END   if (MK_N_LAUNCHES == 1) xcd_barrier(bar, fresh_tid(wave0)); } ++phase;

    bf16_t* H = (bf16_t*)(ws + WS_H); bf16_t* BIG = (bf16_t*)(ws + WS_BIG); bf16_t* ATT = (bf16_t*)(ws + WS_ATT);
    float* mods = (float*)(ws + WS_MODS);

    PH_BEGIN { if (EN(0)) { prologue_phase(ws, lds, G, wg, tid, wave, lane); } } PH_END
    PH_BEGIN { if (EN(1)) { mods_finalize(lds, ws, G, wg, tid); } } PH_END

    layer_phases<0>(lds, ws, out, ctl, bar, G, wg, wave0, lo, hi_, phase);
    layer_phases<1>(lds, ws, out, ctl, bar, G, wg, wave0, lo, hi_, phase);
    PH_BEGIN { if (EN(4)) { final_norm_phase((bf16_t*)(ws + WS_XB), out, inp(lds, 28), SampleFix{(const float*)(ws + WS_PART), 15, (const float*)(ws + WS_MODS) + (size_t)16 * NADA + 8 * DM, 0.5f}, G, wg, wave, lane); } } }
#undef PH_BEGIN
#undef PH_END
}
constexpr int N_PHASES = 64;

extern "C" void kernel_launch(void* const* d_in, const int* in_sizes, int n_in, void* d_out, int out_size, void* d_ws, size_t ws_size, hipStream_t stream) {
    static int grid = 0;
    if (grid == 0) {
        if (n_in != 29 || (size_t)out_size != OUT_TOTAL || ws_size < WS_END) { fprintf(stderr, "kernel_launch: unexpected shapes (n_in %d, out %d, ws %zu; need ws >= %zu)\n", n_in, out_size, ws_size, (size_t)WS_END); grid = -1; return; }
        int dev = 0, cus = 0;
        if (hipGetDevice(&dev) != hipSuccess || hipDeviceGetAttribute(&cus, hipDeviceAttributeMultiprocessorCount, dev) != hipSuccess) { grid = -1; return; }
        if (hipFuncSetAttribute((const void*)mega_fwd, hipFuncAttributeMaxDynamicSharedMemorySize, LDS_BYTES) != hipSuccess) { fprintf(stderr, "kernel_launch: hipFuncSetAttribute failed\n"); grid = -1; return; }
        int per_cu = 0;
        if (hipOccupancyMaxActiveBlocksPerMultiprocessor(&per_cu, (const void*)mega_fwd, 512, LDS_BYTES) != hipSuccess || per_cu < 1) { fprintf(stderr, "kernel_launch: occupancy query says %d blocks per CU\n", per_cu); }
        (void)hipGetLastError();
        grid = cus;
    }
    if (grid < 0) return;
    (void)hipMemsetAsync((char*)d_ws + WS_CTL, 0, 128 * 1024, stream);
    KArgs a{};
    for (int i = 0; i < 29; ++i) a.in.p[i] = (const float*)d_in[i];
    a.out = (float*)d_out; a.ws = (unsigned char*)d_ws;
    if (MK_N_LAUNCHES == 1) { a.ph_lo = 0; a.ph_hi = N_PHASES; hipLaunchKernelGGL(mega_fwd, dim3(grid), dim3(512), LDS_BYTES, stream, a); }
    else { for (int p = 0; p < N_PHASES; ++p) { a.ph_lo = p; a.ph_hi = p + 1; hipLaunchKernelGGL(mega_fwd, dim3(grid), dim3(512), LDS_BYTES, stream, a); } }
}
```

```cpp
#include <hip/hip_runtime.h>
#include <cstdio>
#include <cstdint>

#ifndef MK_N_LAUNCHES
#define MK_N_LAUNCHES 1
#endif

#ifndef DIS
#define DIS 0
#endif
#define EN(bit) (!(((DIS) >> (bit)) & 1))
#define LAS __attribute__((address_space(3)))
typedef unsigned short bf16_t;
typedef short bf16x8 __attribute__((ext_vector_type(8)));
typedef short s16x4 __attribute__((ext_vector_type(4)));
typedef float f32x4 __attribute__((ext_vector_type(4)));
typedef float f32x16 __attribute__((ext_vector_type(16)));
typedef unsigned u32x4 __attribute__((ext_vector_type(4)));
typedef unsigned u32x2 __attribute__((ext_vector_type(2)));

constexpr int DM = 2048, NBATCH = 8, SEQ = 4096, DSEQ = 64, PAST = 4096, DFF = 5504, NADA = 9 * DM;
constexpr int MP = NBATCH * SEQ, MS = NBATCH * DSEQ, MROWS = MP + MS;
constexpr int NQKV = 6144, LD_WINAB = 6152;
constexpr float LOG2E = 1.4426950408889634f;
constexpr float QSCALE_A = 0.125f * LOG2E;
constexpr float QSCALE_B = 0.08838834764831845f * LOG2E;
constexpr float EPS = 1e-6f;

constexpr size_t OFF_Y = 0;
constexpr size_t OFF_AKP = 68157440, OFF_AVP = 101711872, OFF_BKP = 135266304, OFF_BVP = 168820736, OFF_BFP = 202375168;
constexpr size_t OFF_CKP = 202637312, OFF_CVP = 211025920;
constexpr size_t OFF_AKS = 219414528, OFF_AVS = 219938816, OFF_BKS = 220463104, OFF_BVS = 220987392, OFF_BFS = 221511680;
constexpr size_t OFF_CKS = 221515776, OFF_CVS = 222564352, OUT_TOTAL = 223612928;

constexpr size_t MiB = 1u << 20;
constexpr size_t WS_CTL = 0, CTL_BYTES = 1 * MiB;
constexpr size_t SZ_WFI = (size_t)11008 * 2048 * 2, SZ_WFO = (size_t)2048 * 5504 * 2;
constexpr size_t WS_WFI = 1 * MiB;
constexpr size_t WS_WFO = WS_WFI + 4 * SZ_WFI;
constexpr size_t WS_WINAB = WS_WFO + 4 * SZ_WFO;
constexpr size_t WS_WOUTAB = WS_WINAB + 24 * MiB;
constexpr size_t WS_WINC = WS_WOUTAB + 8 * MiB;
constexpr size_t WS_WOUTC = WS_WINC + 24 * MiB;
constexpr size_t WS_H = WS_WOUTC + 8 * MiB;
constexpr size_t WS_BIG = WS_H + 130 * MiB;
constexpr size_t WS_ATT = WS_BIG + 390 * MiB;
constexpr size_t WS_MODP = WS_ATT + 130 * MiB;
constexpr size_t WS_MODS = WS_MODP + 18 * MiB;
constexpr size_t WS_FP = WS_MODS + 3 * MiB;
constexpr size_t WS_FS = WS_FP + 1 * MiB;
constexpr size_t WS_O1 = WS_FS + 2 * MiB;
constexpr size_t WS_PART = WS_O1 + 32 * MiB;
constexpr size_t WS_XB = WS_PART + 60 * MiB;
constexpr size_t WS_END = WS_XB + 130 * MiB;

constexpr int CW_BAR = 4096;
constexpr int CW_Q0 = 16384, CW_Q1 = 16384 + 64;
constexpr int CW_KMX = 16384 + 256, CW_KDONE = 16384 + 512;

constexpr int RING_BYTES = 131072;
constexpr int LDSCTL_OFF = RING_BYTES, MISC_OFF = LDSCTL_OFF + 320, PTAB_OFF = LDSCTL_OFF + 1024;
constexpr int LDS_BYTES = 147456;

#define LDS_WAIT() asm volatile("s_waitcnt lgkmcnt(0)" ::: "memory")
#define VM_WAIT() asm volatile("s_waitcnt vmcnt(0)" ::: "memory")
#define SBAR() __builtin_amdgcn_sched_barrier(0)

__device__ __forceinline__ int fresh_tid(int wave_s) { asm volatile("" : "+s"(wave_s)); int l;
    asm volatile("v_mbcnt_lo_u32_b32 %0, -1, 0\n\tv_mbcnt_hi_u32_b32 %0, -1, %0" : "=v"(l));
    return wave_s * 64 + l; }
__device__ __forceinline__ int fresh_s(int x) { asm volatile("" : "+s"(x)); return x; }
__device__ __forceinline__ unsigned cvtpk(float lo, float hi) { unsigned r; asm volatile("v_cvt_pk_bf16_f32 %0, %1, %2" : "=v"(r) : "v"(lo), "v"(hi)); return r; }
__device__ __forceinline__ bf16x8 pack8(f32x4 a, f32x4 b) {
    u32x4 w = {cvtpk(a[0], a[1]), cvtpk(a[2], a[3]), cvtpk(b[0], b[1]), cvtpk(b[2], b[3])};
    return *reinterpret_cast<bf16x8*>(&w);
}
__device__ __forceinline__ float wave_sum(float v) {
#pragma unroll
    for (int o = 1; o < 64; o <<= 1) v += __shfl_xor(v, o);
    return v;
}

namespace pg8 {
#define PG8_LAS __attribute__((address_space(3)))
constexpr int BM = 256, BK = 64, HALF = 128, HTB = HALF * BK * 2, STAGE_BYTES = 8 * HTB, NXCD = 8, WGM = 8;
__host__ __device__ __forceinline__ int lds_byte(int r, int c) { const int st = (r >> 4) * 2 + (c >> 5), rr = r & 15, cc = c & 31, ob = rr * 64 + cc * 2; return st * 1024 + (ob ^ (((ob >> 9) & 1) << 5)); }
__host__ __device__ __forceinline__ void stage_rc(int b, int& R, int& C) { const int st = b / 1024, sb = b % 1024, swz = sb ^ (((sb >> 9) & 1) << 5); R = (st >> 1) * 16 + swz / 64; C = (st & 1) * 32 + (swz % 64) / 2; }
__host__ __device__ __forceinline__ int perm32(int rho) { const int n = rho >> 4, i = rho & 15; return 8 * (i >> 2) + 4 * n + (i & 3); }
struct Unit { int pm, pn, kofs, nt, part; };
struct Gemm { const bf16_t* A; const bf16_t* Bt; int M, N, K; };
struct StaticOrder {
    int nM, nN, nwg, G, c, ntk, wgm;
    __host__ __device__ __forceinline__ void init(int M, int N, int G_, int c_) { nM = M / BM; nN = N / BM; nwg = nM * nN; G = G_; c = c_; ntk = 0; wgm = 4; }
    __host__ __device__ __forceinline__ bool next(int i, Unit& u) const {
        const long L = (long)i * G + c; if (L >= nwg) return false;
        int wgid = (int)L; { const int q = nwg / NXCD, r = nwg % NXCD, xcd = wgid % NXCD, off = wgid / NXCD; wgid = (xcd < r ? xcd * (q + 1) : r * (q + 1) + (xcd - r) * q) + off; }
        const int nig = wgm * nN, gid = wgid / nig, fm = gid * wgm, gsz = (nM - fm) < wgm ? (nM - fm) : wgm;
        u.pm = fm + ((wgid % nig) % gsz); u.pn = (wgid % nig) / gsz; u.kofs = 0; u.nt = ntk; u.part = -1; return true;
    }
    __device__ __forceinline__ void a_ready(const Unit&) const {}
    __device__ __forceinline__ void done(const Unit&) const {}
};
struct SplitOrder {
    StaticOrder so; int S, nitems, base, rem, G, c, npre, nmine;
    __device__ __forceinline__ void init(int Kfull, int N, int S_, int G_, int c_) { so.init(MP, N, G_, c_); so.ntk = Kfull / BK; if (N / BM == 8) so.wgm = 4; S = S_; nitems = 2 * (N / BM) * S; const int chunks = Kfull / 128; base = chunks / S; rem = chunks % S; G = G_; c = c_;
        npre = ((c & 1) && c < nitems) ? 1 : 0; nmine = (so.nwg > c) ? (so.nwg - 1 - c) / G + 1 : 0; }
    __device__ __forceinline__ bool next(int i, Unit& u) const {
        const int j = i - npre;
        if (j >= 0 && j < nmine) return so.next(j, u);
        if (c >= nitems || !((npre && i == 0) || (!npre && j == nmine))) return false;
        const int unit = c / S, s = c % S, start = s * base + (s < rem ? s : rem), len = base + (s < rem ? 1 : 0);
        u.pm = MP / BM + unit / (so.nN); u.pn = unit % so.nN; u.kofs = start * 128; u.nt = len * 2; u.part = s; return true;
    }
    __device__ __forceinline__ void a_ready(const Unit&) const {}
    __device__ __forceinline__ void done(const Unit&) const {}
};
template <class Epi, class Sched, bool ALIGN_EPI = false, bool SP2 = false>
__device__ __forceinline__ void gemm_phase(PG8_LAS unsigned char* lds, const Gemm g, const Sched& S, const Epi& E, int wave_s) {
    const int tid = fresh_tid(wave_s), wid = __builtin_amdgcn_readfirstlane(tid >> 6), lane = tid & 63, wr = wid >> 2, wc = wid & 3, fr = lane & 15, fq = lane >> 4;
    const int K = g.K;
    unsigned voffA[2], voffB[2];
#pragma unroll
    for (int i = 0; i < 2; ++i) { int R, C; stage_rc(tid * 16 + i * 8192, R, C); const int Rb = Epi::PERM ? ((R & ~31) + perm32(R & 31)) : R;
        voffA[i] = (unsigned)(R * K + C) * 2u; voffB[i] = (unsigned)(Rb * K + C) * 2u; }
    const size_t kstep = (size_t)(BK * 2);
    const size_t hstep = (size_t)HALF * K * 2;
    const size_t tstep = 2 * hstep;
    const unsigned ldsw = (unsigned)wid * 1024u;
    const int aoff = lds_byte(wr * 64 + fr, fq * 8), boff = lds_byte(wc * 32 + fr, fq * 8);
#define PG8_SA(b, h) (((b) * 2 + (h)) * HTB)
#define PG8_SB(b, h) ((4 + (b) * 2 + (h)) * HTB)
#define PG8_STAGE(bufoff, gbase, voff) do { _Pragma("unroll") for (int _i = 0; _i < 2; ++_i) \
        __builtin_amdgcn_global_load_lds((const unsigned*)((const char*)(gbase) + (voff)[_i]), (PG8_LAS unsigned*)(lds + (bufoff) + ldsw + _i * 8192), 16, 0, 0); } while (0)
#define PG8_LDA(dst, b, h) do { _Pragma("unroll") for (int m = 0; m < 4; ++m) _Pragma("unroll") for (int k = 0; k < 2; ++k) dst[m][k] = *(const PG8_LAS bf16x8*)(lds + PG8_SA(b, h) + aoff + m * 2048 + k * 1024); } while (0)
#define PG8_LDB(dst, b, h) do { _Pragma("unroll") for (int n = 0; n < 2; ++n) _Pragma("unroll") for (int k = 0; k < 2; ++k) dst[n][k] = *(const PG8_LAS bf16x8*)(lds + PG8_SB(b, h) + boff + n * 2048 + k * 1024); } while (0)
#define PG8_MMA(ai, bj, At, Bt) do { __builtin_amdgcn_s_setprio(1); _Pragma("unroll") for (int m = 0; m < 4; ++m) _Pragma("unroll") for (int n = 0; n < 2; ++n) _Pragma("unroll") for (int k = 0; k < 2; ++k) \
        acc[ai][bj][m][n] = __builtin_amdgcn_mfma_f32_16x16x32_bf16(Bt[n][k], At[m][k], acc[ai][bj][m][n], 0, 0, 0); __builtin_amdgcn_s_setprio(0); } while (0)
#define PG8_WAIT_V(n) asm volatile("s_waitcnt vmcnt(" #n ")" ::: "memory")
#define PG8_WAIT_L(n) asm volatile("s_waitcnt lgkmcnt(" #n ")" ::: "memory")
#define PG8_BAR __builtin_amdgcn_s_barrier()
#define PG8_SCHED __builtin_amdgcn_sched_barrier(0)
    Unit cur, nxt; int ui = 0;
    if (!S.next(0, cur)) return;
    f32x4 acc[2][2][4][2];
#pragma unroll
    for (int a = 0; a < 2; ++a)
#pragma unroll
        for (int b = 0; b < 2; ++b)
#pragma unroll
            for (int m = 0; m < 4; ++m)
#pragma unroll
                for (int n = 0; n < 2; ++n) acc[a][b][m][n] = (f32x4){0.f, 0.f, 0.f, 0.f};
    bf16x8 At[4][2], B0[2][2], B1[2][2];
    int nt = cur.nt;
    const char* cA = (const char*)g.A + (size_t)cur.pm * tstep + (size_t)cur.kofs * 2; const char* cB = (const char*)g.Bt + (size_t)cur.pn * tstep + (size_t)cur.kofs * 2;
    S.a_ready(cur);
    if constexpr (SP2) {
        PG8_STAGE(PG8_SB(0, 0), cB, voffB); PG8_STAGE(PG8_SB(0, 1), cB + hstep, voffB); PG8_STAGE(PG8_SA(0, 0), cA, voffA); PG8_STAGE(PG8_SA(0, 1), cA + hstep, voffA);
        if (wr == 1) PG8_BAR;
        PG8_WAIT_V(2); PG8_BAR;
        PG8_STAGE(PG8_SB(1, 0), cB + kstep, voffB); PG8_STAGE(PG8_SA(1, 0), cA + kstep, voffA); PG8_STAGE(PG8_SB(1, 1), cB + hstep + kstep, voffB);
        PG8_WAIT_V(6); PG8_BAR;
    } else {
        PG8_STAGE(PG8_SB(0, 0), cB, voffB); PG8_STAGE(PG8_SA(0, 0), cA, voffA); PG8_STAGE(PG8_SB(0, 1), cB + hstep, voffB); PG8_STAGE(PG8_SA(0, 1), cA + hstep, voffA);
        if (wr == 1) PG8_BAR;
        PG8_WAIT_V(4); PG8_BAR;
        PG8_STAGE(PG8_SB(1, 0), cB + kstep, voffB); PG8_STAGE(PG8_SA(1, 0), cA + kstep, voffA); PG8_STAGE(PG8_SB(1, 1), cB + hstep + kstep, voffB);
        PG8_WAIT_V(6); PG8_BAR;
    }
    for (;;) {
        const bool has_next = S.next(ui + 1, nxt);
        const char* nA = has_next ? (const char*)g.A + (size_t)nxt.pm * tstep + (size_t)nxt.kofs * 2 : cA; const char* nB = has_next ? (const char*)g.Bt + (size_t)nxt.pn * tstep + (size_t)nxt.kofs * 2 : cB;
        for (int t = 0; t < nt; t += 2) {
            const bool last = (t == nt - 2);
            const char* a1 = cA + (size_t)(t + 1) * kstep;
            const char* a2 = last ? nA : cA + (size_t)(t + 2) * kstep; const char* b2 = last ? nB : cB + (size_t)(t + 2) * kstep;
            const char* a3 = a2 + kstep; const char* b3 = b2 + kstep;
            if (last && has_next) S.a_ready(nxt);
            if constexpr (SP2) {
            PG8_LDB(B0, 0, 0); PG8_LDB(B1, 0, 1); PG8_SCHED; PG8_LDA(At, 0, 0); PG8_STAGE(PG8_SA(1, 1), a1 + hstep, voffA);
            PG8_WAIT_V(8); PG8_WAIT_L(0); PG8_BAR; PG8_MMA(0, 0, At, B0); PG8_MMA(0, 1, At, B1); PG8_BAR; PG8_SCHED;
            PG8_LDA(At, 0, 1); PG8_STAGE(PG8_SB(0, 0), b2, voffB); PG8_STAGE(PG8_SB(0, 1), b2 + hstep, voffB); PG8_STAGE(PG8_SA(0, 0), a2, voffA);
            PG8_WAIT_V(8); PG8_WAIT_L(0); PG8_BAR; PG8_MMA(1, 0, At, B0); PG8_MMA(1, 1, At, B1); PG8_BAR; PG8_SCHED;
            PG8_LDB(B0, 1, 0); PG8_LDB(B1, 1, 1); PG8_SCHED; PG8_LDA(At, 1, 0); PG8_STAGE(PG8_SA(0, 1), a2 + hstep, voffA);
            PG8_WAIT_V(8); PG8_WAIT_L(0); PG8_BAR; PG8_MMA(0, 0, At, B0); PG8_MMA(0, 1, At, B1); PG8_BAR; PG8_SCHED;
            PG8_LDA(At, 1, 1); PG8_STAGE(PG8_SB(1, 0), b3, voffB); PG8_STAGE(PG8_SB(1, 1), b3 + hstep, voffB); PG8_STAGE(PG8_SA(1, 0), a3, voffA);
            PG8_WAIT_V(8); PG8_WAIT_L(0); PG8_BAR; PG8_MMA(1, 0, At, B0); PG8_MMA(1, 1, At, B1); PG8_BAR; PG8_SCHED;
            } else {
            PG8_LDB(B0, 0, 0); PG8_SCHED; PG8_LDA(At, 0, 0); PG8_STAGE(PG8_SA(1, 1), a1 + hstep, voffA);
            PG8_WAIT_L(8); PG8_BAR; PG8_WAIT_L(0); PG8_MMA(0, 0, At, B0); PG8_BAR; PG8_SCHED;
            PG8_LDB(B1, 0, 1); PG8_STAGE(PG8_SB(0, 0), b2, voffB);
            PG8_BAR; PG8_WAIT_L(0); PG8_MMA(0, 1, At, B1); PG8_BAR;
            PG8_LDA(At, 0, 1); PG8_STAGE(PG8_SA(0, 0), a2, voffA);
            PG8_BAR; PG8_WAIT_L(0); PG8_MMA(1, 0, At, B0); PG8_BAR; PG8_SCHED;
            PG8_STAGE(PG8_SB(0, 1), b2 + hstep, voffB);
            PG8_WAIT_V(6); PG8_BAR; PG8_MMA(1, 1, At, B1); PG8_BAR;
            PG8_LDB(B0, 1, 0); PG8_SCHED; PG8_LDA(At, 1, 0); PG8_STAGE(PG8_SA(0, 1), a2 + hstep, voffA);
            PG8_WAIT_L(8); PG8_BAR; PG8_WAIT_L(0); PG8_MMA(0, 0, At, B0); PG8_BAR; PG8_SCHED;
            PG8_LDB(B1, 1, 1); PG8_STAGE(PG8_SB(1, 0), b3, voffB);
            PG8_BAR; PG8_WAIT_L(0); PG8_MMA(0, 1, At, B1); PG8_BAR;
            PG8_LDA(At, 1, 1); PG8_STAGE(PG8_SA(1, 0), a3, voffA);
            PG8_BAR; PG8_WAIT_L(0); PG8_MMA(1, 0, At, B0); PG8_BAR; PG8_SCHED;
            PG8_STAGE(PG8_SB(1, 1), b3 + hstep, voffB);
            PG8_WAIT_V(6); PG8_BAR; PG8_MMA(1, 1, At, B1); PG8_BAR;
            }
        }
        if constexpr (ALIGN_EPI) { if (wr == 0) PG8_BAR; }
        E(acc, cur, wr, wc, fr, fq);
        if (!has_next) break;
#pragma unroll
        for (int a = 0; a < 2; ++a)
#pragma unroll
            for (int b = 0; b < 2; ++b)
#pragma unroll
                for (int m = 0; m < 4; ++m)
#pragma unroll
                    for (int n = 0; n < 2; ++n) acc[a][b][m][n] = (f32x4){0.f, 0.f, 0.f, 0.f};
        cur = nxt; cA = nA; cB = nB; ++ui; nt = cur.nt;
        if constexpr (ALIGN_EPI) { if (wr == 1) PG8_BAR; }
    }
    PG8_WAIT_V(0);
    if constexpr (!ALIGN_EPI) { if (wr == 0) PG8_BAR; }
    PG8_BAR;
#undef PG8_SA
#undef PG8_SB
#undef PG8_STAGE
#undef PG8_LDA
#undef PG8_LDB
#undef PG8_MMA
#undef PG8_WAIT_V
#undef PG8_WAIT_L
#undef PG8_BAR
#undef PG8_SCHED
}
}

struct EpiSwiGLU {
    static constexpr bool PERM = true;
    bf16_t* O;
    __device__ __forceinline__ void operator()(const f32x4 (&acc)[2][2][4][2], const pg8::Unit& u, int wr, int wc, int fr, int fq) const {
        const int row0 = u.pm * 256 + wr * 64 + fr, col0 = u.pn * 128 + wc * 32 + 8 * fq;
#pragma unroll
        for (int ai = 0; ai < 2; ++ai)
#pragma unroll
            for (int m = 0; m < 4; ++m) {
                bf16_t* rowp = O + (size_t)(row0 + ai * 128 + m * 16) * DFF + col0;
                float v[8];
#pragma unroll
                for (int n = 0; n < 2; ++n)
#pragma unroll
                    for (int j = 0; j < 4; ++j) {
                        const float t = acc[ai][0][m][n][j], uu = acc[ai][1][m][n][j];
                        v[n * 4 + j] = (t * uu) * __builtin_amdgcn_rcpf(1.0f + __builtin_amdgcn_exp2f(t));
                    }
                u32x4 w; w.x = cvtpk(v[0], v[1]); w.y = cvtpk(v[2], v[3]); w.z = cvtpk(v[4], v[5]); w.w = cvtpk(v[6], v[7]);
                *(u32x4*)rowp = w;
            }
    }
};
struct EpiResGate {
    static constexpr bool PERM = true;
    const float* xin_p;
    bf16_t* xb;
    const float* gate;
    float coef;
    float* part;
    __device__ __forceinline__ void operator()(const f32x4 (&acc)[2][2][4][2], const pg8::Unit& u, int wr, int wc, int fr, int fq) const {
        const int row0 = u.pm * 256 + wr * 64 + fr, col0 = u.pn * 256 + wc * 32 + 8 * fq;
        if (u.part >= 0) {
            float* pp = part + ((size_t)u.part * MS + (row0 - MP)) * DM + col0;
#pragma unroll
            for (int ai = 0; ai < 2; ++ai)
#pragma unroll
                for (int m = 0; m < 4; ++m)
#pragma unroll
                    for (int bj = 0; bj < 2; ++bj)
#pragma unroll
                        for (int n = 0; n < 2; ++n) *(f32x4*)(pp + (size_t)(ai * 128 + m * 16) * DM + bj * 128 + n * 4) = acc[ai][bj][m][n];
            return;
        }
        const int modrow = u.pm >> 4;
        const float* gp = gate + (size_t)modrow * NADA + col0;
        f32x4 gv[2][2];
#pragma unroll
        for (int bj = 0; bj < 2; ++bj)
#pragma unroll
            for (int n = 0; n < 2; ++n) gv[bj][n] = *(const f32x4*)(gp + bj * 128 + n * 4) * coef;
#pragma unroll
        for (int ai = 0; ai < 2; ++ai)
#pragma unroll
            for (int m = 0; m < 4; ++m) {
                const size_t off = (size_t)(row0 + ai * 128 + m * 16) * DM + col0;
#pragma unroll
                for (int bj = 0; bj < 2; ++bj) {
                    f32x4 x0, x1;
                    if (xin_p) { x0 = *(const f32x4*)(xin_p + off + bj * 128); x1 = *(const f32x4*)(xin_p + off + bj * 128 + 4); }
                    else { const u32x4 w = *(const u32x4*)(xb + off + bj * 128);
                        x0 = (f32x4){__uint_as_float(w.x << 16), __uint_as_float(w.x & 0xffff0000u), __uint_as_float(w.y << 16), __uint_as_float(w.y & 0xffff0000u)};
                        x1 = (f32x4){__uint_as_float(w.z << 16), __uint_as_float(w.z & 0xffff0000u), __uint_as_float(w.w << 16), __uint_as_float(w.w & 0xffff0000u)}; }
                    x0 += gv[bj][0] * acc[ai][bj][m][0]; x1 += gv[bj][1] * acc[ai][bj][m][1];
                    u32x4 o; o.x = cvtpk(x0[0], x0[1]); o.y = cvtpk(x0[2], x0[3]); o.z = cvtpk(x1[0], x1[1]); o.w = cvtpk(x1[2], x1[3]);
                    *(u32x4*)(xb + off + bj * 128) = o;
                }
            }
    }
};
struct EpiQKV {
    static constexpr bool PERM = true;
    bf16_t* O;
    float* out;
    int layer1;
    float* part;
    __device__ __forceinline__ void operator()(const f32x4 (&acc)[2][2][4][2], const pg8::Unit& u, int wr, int wc, int fr, int fq) const {
        if (u.part >= 0) {
            float* pp = part + ((size_t)u.part * MS + (u.pm * 256 - MP + wr * 64 + fr)) * NQKV + u.pn * 256 + wc * 32 + 8 * fq;
#pragma unroll
            for (int ai = 0; ai < 2; ++ai)
#pragma unroll
                for (int m = 0; m < 4; ++m)
#pragma unroll
                    for (int bj = 0; bj < 2; ++bj)
#pragma unroll
                        for (int n = 0; n < 2; ++n) *(f32x4*)(pp + (size_t)(ai * 128 + m * 16) * NQKV + bj * 128 + n * 4) = acc[ai][bj][m][n];
            return;
        }
        const int sh = layer1 ? 3 : 2;
        const int sec = u.pn >> sh, colw = (u.pn & ((1 << sh) - 1)) * 256, ldf = 256 << sh;
        const int row0 = u.pm * 256 + wr * 64 + fr, cw = wc * 32 + 8 * fq;
        const bool samp = u.pm >= 128;
        size_t fo = 0;
        if (!layer1) { if (sec == 1) fo = samp ? OFF_AKS : OFF_AKP; else if (sec == 2) fo = samp ? OFF_AVS : OFF_AVP; else if (sec == 4) fo = samp ? OFF_BKS : OFF_BKP; else if (sec == 5) fo = samp ? OFF_BVS : OFF_BVP; }
        else { if (sec == 1) fo = samp ? OFF_CKS : OFF_CKP; else if (sec == 2) fo = samp ? OFF_CVS : OFF_CVP; }
        float* fdst = nullptr;
        if (fo) {
            if (samp) fdst = out + fo + (size_t)(u.pm * 256 - MP) * ldf;
            else if (!layer1) fdst = out + fo + (size_t)(u.pm * 256) * ldf;
            else if ((u.pm & 15) >= 14) { const int b = u.pm >> 4; fdst = out + fo + (size_t)(u.pm * 256 - (b + 1) * 3584) * ldf; }
        }
#pragma unroll
        for (int ai = 0; ai < 2; ++ai)
#pragma unroll
            for (int m = 0; m < 4; ++m) {
                const int rl = ai * 128 + m * 16;
                bf16_t* rowp = O + (size_t)(row0 + rl) * NQKV + u.pn * 256 + cw;
#pragma unroll
                for (int bj = 0; bj < 2; ++bj) {
                    const f32x4 v0 = acc[ai][bj][m][0], v1 = acc[ai][bj][m][1];
                    u32x4 w; w.x = cvtpk(v0[0], v0[1]); w.y = cvtpk(v0[2], v0[3]); w.z = cvtpk(v1[0], v1[1]); w.w = cvtpk(v1[2], v1[3]);
                    *(u32x4*)(rowp + bj * 128) = w;
                    if (fdst) { float* fr_ = fdst + (size_t)(wr * 64 + fr + rl) * ldf + colw + bj * 128 + cw;
                        __builtin_nontemporal_store(v0, (f32x4*)fr_); __builtin_nontemporal_store(v1, (f32x4*)(fr_ + 4)); }
                }
            }
    }
};

#define XB_TMO      128
#define XB_XCNT(j)  (256  + 64 * (j))
#define XB_XSUB(j)  (1280 + 64 * (j))
#define XB_XGEN(j)  (2304 + 64 * (j))
#define XB_TOP      3328
#define XB_TOPGEN   3392
#define XCD_BAR_WORDS 3456
#define XB_SPIN_CAP (1u << 18)
__device__ __forceinline__ unsigned xb_ld(unsigned* p)              { return __hip_atomic_load(p, __ATOMIC_RELAXED, __HIP_MEMORY_SCOPE_AGENT); }
__device__ __forceinline__ unsigned xb_add(unsigned* p, unsigned v) { return __hip_atomic_fetch_add(p, v, __ATOMIC_RELAXED, __HIP_MEMORY_SCOPE_AGENT); }
__device__ __forceinline__ unsigned xb_xcc_id() { return (unsigned)__builtin_amdgcn_s_getreg((3 << 11) | 20) & 0xFu; }
#define XB_SPIN(cond, bar) do { unsigned _sp = 0; while (cond) { __builtin_amdgcn_s_sleep(1); \
    if ((++_sp & 255u) == 0u) { if (xb_ld(&(bar)[XB_TMO])) break; if (_sp > XB_SPIN_CAP) { atomicAdd(&(bar)[XB_TMO], 1u); break; } } } } while (0)
struct XcdBarrier { unsigned* bar; unsigned x; volatile LAS unsigned* st; };
__device__ __forceinline__ XcdBarrier xcd_barrier_post(unsigned* bar, volatile LAS unsigned* st, int tid) {
    XcdBarrier b; b.bar = bar; b.x = xb_xcc_id(); b.st = st;
    if (tid == 0) (void)xb_add(&bar[XB_XCNT(b.x)], 1u);
    return b;
}
__device__ __forceinline__ void xcd_barrier_complete(unsigned* bar, unsigned x, unsigned& nloc, unsigned& nx) {
    const unsigned G = gridDim.x * gridDim.y * gridDim.z;
    unsigned sum, cnt, mine, sp = 0u;
    for (;;) {
        sum = 0u; cnt = 0u; mine = 0u;
#pragma unroll
        for (unsigned j = 0; j < 16; ++j) { const unsigned c = xb_ld(&bar[XB_XCNT(j)]); sum += c; cnt += (c > 0u) ? 1u : 0u; }
        mine = xb_ld(&bar[XB_XCNT(x)]);
        if (sum == G) break;
        __builtin_amdgcn_s_sleep(1);
        if ((++sp & 255u) == 0u) { if (xb_ld(&bar[XB_TMO])) break; if (sp > XB_SPIN_CAP) { atomicAdd(&bar[XB_TMO], 1u); break; } }
    }
    nloc = mine > 0u ? mine : 1u; nx = cnt > 0u ? cnt : 1u;
}
__device__ __forceinline__ void xcd_barrier(const XcdBarrier& b, int tid) {
    asm volatile("s_waitcnt vmcnt(0)" ::: "memory");
    __syncthreads();
    if (tid == 0) {
        unsigned* bar = b.bar; asm volatile("" : "+s"(bar));
        __builtin_amdgcn_s_waitcnt(0);
        unsigned nloc = b.st[0], nx = b.st[1];
        if (nloc == 0u) { xcd_barrier_complete(bar, b.x, nloc, nx); b.st[0] = nloc; b.st[1] = nx; }
        const unsigned old = xb_add(&bar[XB_XSUB(b.x)], 1u);
        const unsigned gen = old / nloc;
        if (old + 1u == (gen + 1u) * nloc) {
            __builtin_amdgcn_fence(__ATOMIC_RELEASE, "agent");
            asm volatile("s_waitcnt vmcnt(0)" ::: "memory");
            const unsigned og = xb_add(&bar[XB_TOP], 1u);
            const unsigned tg = og / nx;
            if (og + 1u == (tg + 1u) * nx) xb_add(&bar[XB_TOPGEN], 1u);
            else XB_SPIN(xb_ld(&bar[XB_TOPGEN]) == tg, bar);
            __builtin_amdgcn_fence(__ATOMIC_ACQUIRE, "agent");
            xb_add(&bar[XB_XGEN(b.x)], 1u);
            asm volatile("s_waitcnt vmcnt(0)" ::: "memory");
        } else {
            XB_SPIN(xb_ld(&bar[XB_XGEN(b.x)]) == gen, bar);
            __builtin_amdgcn_fence(__ATOMIC_ACQUIRE, "agent");
            asm volatile("s_waitcnt vmcnt(0)" ::: "memory");
        }
    }
    __syncthreads();
}

__device__ __forceinline__ void transpose_block(const float* W, int ldw, int K, bf16_t* WT, int k0, int n0, int swiglu, int lane) {
    const int a = lane & 15, g = lane >> 4;
    const float* src = W + (size_t)(k0 + 16 * g) * ldw + n0 + 4 * a;
    f32x4 v[16];
#pragma unroll
    for (int kk = 0; kk < 16; ++kk) v[kk] = *(const f32x4*)(src + (size_t)kk * ldw);
#pragma unroll
    for (int j = 0; j < 4; ++j) {
        const int n = n0 + 4 * a + j;
        int R = n;
        if (swiglu == 1) { R = (n < DFF) ? ((n >> 7) * 256 + (n & 127)) : (((n - DFF) >> 7) * 256 + 128 + ((n - DFF) & 127));
            const float sc = (n < DFF) ? -LOG2E : -1.0f / LOG2E;
#pragma unroll
            for (int kk = 0; kk < 16; ++kk) v[kk][j] *= sc; }
        if (swiglu >= 2) {
            const float sc = (swiglu == 2) ? ((n < 1024) ? QSCALE_A : ((n >= 3072 && n < 4096) ? QSCALE_B : 1.0f)) : ((n < 2048) ? QSCALE_B : 1.0f);
#pragma unroll
            for (int kk = 0; kk < 16; ++kk) v[kk][j] *= sc; }
        u32x4 w0, w1;
        w0.x = cvtpk(v[0][j], v[1][j]); w0.y = cvtpk(v[2][j], v[3][j]); w0.z = cvtpk(v[4][j], v[5][j]); w0.w = cvtpk(v[6][j], v[7][j]);
        w1.x = cvtpk(v[8][j], v[9][j]); w1.y = cvtpk(v[10][j], v[11][j]); w1.z = cvtpk(v[12][j], v[13][j]); w1.w = cvtpk(v[14][j], v[15][j]);
        bf16_t* dst = WT + (size_t)R * K + k0 + 16 * g;
        *(u32x4*)dst = w0; *(u32x4*)(dst + 8) = w1;
    }
}
struct InPtrs { const float* p[29]; };
__device__ __forceinline__ const float* inp(LAS unsigned char* lds, int i) {
    int off = PTAB_OFF + 8 * i; asm volatile("" : "+v"(off));
    const unsigned long long v = *(volatile LAS unsigned long long*)(lds + off);
    const unsigned lo = __builtin_amdgcn_readfirstlane((unsigned)v), hi = __builtin_amdgcn_readfirstlane((unsigned)(v >> 32));
    return (const float*)(((unsigned long long)hi << 32) | lo);
}

__device__ __forceinline__ void prologue_phase(unsigned char* ws, LAS unsigned char* lds, int G, int wg, int tid, int wave, int lane) {
    const float* w_ada = inp(lds, 11); const float* c_p = inp(lds, 9); const float* c_s = inp(lds, 10);
    float* modp = (float*)(ws + WS_MODP);
    LAS float* sct = (LAS float*)lds;
    LAS f32x4* red = (LAS f32x4*)(lds + 16384);
    for (int u = wg; u < 1152; u += G) {
        const int l = u / 576, r = u % 576, cb = r >> 3, k8 = r & 7, k0 = k8 * 256;
        __syncthreads();
        if (tid < 256) {
            const int k = k0 + tid;
#pragma unroll
            for (int rr = 0; rr < 16; ++rr) { const float c = (rr < 8) ? c_p[rr * DM + k] : c_s[(rr - 8) * DM + k];
                sct[tid * 16 + rr] = c / (1.0f + __expf(-c)); }
        }
        __syncthreads();
        f32x4 acc[16];
#pragma unroll
        for (int rr = 0; rr < 16; ++rr) acc[rr] = (f32x4){0.f, 0.f, 0.f, 0.f};
        const float* wp = w_ada + ((size_t)l * DM + k0 + wave * 32) * NADA + cb * 256 + 4 * lane;
#pragma unroll 4
        for (int kk = 0; kk < 32; ++kk) {
            const f32x4 wv = *(const f32x4*)(wp + (size_t)kk * NADA);
            const LAS f32x4* sp = (const LAS f32x4*)(sct + (wave * 32 + kk) * 16);
            const f32x4 s0 = sp[0], s1 = sp[1], s2 = sp[2], s3 = sp[3];
#pragma unroll
            for (int e = 0; e < 4; ++e) { acc[e] += wv * s0[e]; acc[4 + e] += wv * s1[e]; acc[8 + e] += wv * s2[e]; acc[12 + e] += wv * s3[e]; }
        }
#pragma unroll
        for (int p = 0; p < 2; ++p) {
#pragma unroll
            for (int i = 0; i < 8; ++i) red[(wave * 8 + i) * 64 + lane] = acc[p * 8 + i];
            __syncthreads();
            { const int i = tid >> 6, ln = tid & 63; f32x4 s = red[i * 64 + ln];
#pragma unroll
              for (int w = 1; w < 8; ++w) s += red[(w * 8 + i) * 64 + ln];
              *(f32x4*)(modp + ((size_t)((k8 * 2 + l) * 16 + p * 8 + i)) * NADA + cb * 256 + 4 * ln) = s; }
            __syncthreads();
        }
    }
    constexpr int NB_FI = 32 * 172, NB_FO = 86 * 32, NB_IN = 32 * 96, NB_OUT = 32 * 32;
    constexpr int TOT = 4 * NB_FI + 4 * NB_FO + 2 * NB_IN + 2 * NB_OUT;
    for (int gb = wg * 8 + wave; gb < TOT; gb += G * 8) {
        int g = gb; const float* W; int ldw, K, nb64, swi = 0; bf16_t* WT;
        if (g < 4 * NB_FI) { const int m = g / NB_FI; g -= m * NB_FI; W = inp(lds, 14) + (size_t)m * DM * 11008; ldw = 11008; K = DM; nb64 = 172; swi = 1; WT = (bf16_t*)(ws + WS_WFI + (size_t)m * SZ_WFI); }
        else { g -= 4 * NB_FI;
            if (g < 4 * NB_FO) { const int m = g / NB_FO; g -= m * NB_FO; W = inp(lds, 15) + (size_t)m * DFF * DM; ldw = DM; K = DFF; nb64 = 32; WT = (bf16_t*)(ws + WS_WFO + (size_t)m * SZ_WFO); }
            else { g -= 4 * NB_FO;
                if (g < NB_IN) { W = inp(lds, 16); ldw = LD_WINAB; K = DM; nb64 = 96; swi = 2; WT = (bf16_t*)(ws + WS_WINAB); }
                else { g -= NB_IN;
                    if (g < NB_OUT) { W = inp(lds, 18); ldw = DM; K = DM; nb64 = 32; WT = (bf16_t*)(ws + WS_WOUTAB); }
                    else { g -= NB_OUT;
                        if (g < NB_IN) { W = inp(lds, 25); ldw = NQKV; K = DM; nb64 = 96; swi = 3; WT = (bf16_t*)(ws + WS_WINC); }
                        else { g -= NB_IN; W = inp(lds, 26); ldw = DM; K = DM; nb64 = 32; WT = (bf16_t*)(ws + WS_WOUTC); } } } } }
        const int kb = g / nb64, nb = g % nb64;
        transpose_block(W, ldw, K, WT, kb * 64, nb * 64, swi, lane);
    }
}
__device__ __forceinline__ void mods_finalize(LAS unsigned char* lds, unsigned char* ws, int G, int wg, int tid) {
    const float* modp = (const float*)(ws + WS_MODP); float* mods = (float*)(ws + WS_MODS); const float* b_ada = inp(lds, 12);
    constexpr int NV = 2 * 16 * NADA / 4;
    for (int i = wg * 512 + tid; i < NV; i += G * 512) {
        const int e = i * 4, l = e / (16 * NADA), rem = e % (16 * NADA), r = rem / NADA, j = rem % NADA;
        f32x4 s = *(const f32x4*)(b_ada + (size_t)l * NADA + j);
#pragma unroll
        for (int k8 = 0; k8 < 8; ++k8) s += *(const f32x4*)(modp + ((size_t)((k8 * 2 + l) * 16 + r)) * NADA + j);
        *(f32x4*)(mods + e) = s;
    }
}

__device__ __forceinline__ void load_row(f32x4 (&v)[8], const float* x32, const bf16_t* xb, int lane) {
    if (x32) {
#pragma unroll
        for (int j = 0; j < 8; ++j) v[j] = *(const f32x4*)(x32 + 4 * lane + 256 * j);
    } else {
#pragma unroll
        for (int j = 0; j < 8; ++j) { const u32x2 w = *(const u32x2*)(xb + 4 * lane + 256 * j);
            v[j] = (f32x4){__uint_as_float(w.x << 16), __uint_as_float(w.x & 0xffff0000u), __uint_as_float(w.y << 16), __uint_as_float(w.y & 0xffff0000u)}; }
    }
}
struct SampleFix { const float* part; int S; const float* gate; float coef; };
__device__ __forceinline__ void sample_fix(f32x4 (&v)[8], const SampleFix& fx, int srow, bf16_t* xb_row, int lane) {
    f32x4 acc[8];
#pragma unroll
    for (int j = 0; j < 8; ++j) acc[j] = (f32x4){0.f, 0.f, 0.f, 0.f};
#pragma unroll 1
    for (int sl = 0; sl < fx.S; ++sl) { const float* pp = fx.part + ((size_t)sl * MS + srow) * DM + 4 * lane;
#pragma unroll
        for (int j = 0; j < 8; ++j) acc[j] += *(const f32x4*)(pp + 256 * j); }
    const float* gp = fx.gate + (size_t)(8 + (srow >> 6)) * NADA + 4 * lane;
#pragma unroll
    for (int j = 0; j < 8; ++j) { v[j] += *(const f32x4*)(gp + 256 * j) * fx.coef * acc[j];
        u32x2 w; w.x = cvtpk(v[j][0], v[j][1]); w.y = cvtpk(v[j][2], v[j][3]);
        *(u32x2*)(xb_row + 4 * lane + 256 * j) = w;
        v[j] = (f32x4){__uint_as_float(w.x << 16), __uint_as_float(w.x & 0xffff0000u), __uint_as_float(w.y << 16), __uint_as_float(w.y & 0xffff0000u)}; }
}
template <bool FGATE>
__device__ __forceinline__ void norm_row(f32x4 (&v)[8], bf16_t* hrow, const f32x4 (&gs)[8], const f32x4 (&sh)[8], int lane,
                                         const LAS f32x4* wfA, const LAS f32x4* wfB, const float* bf, float* fout) {
    float ss = 0.f;
#pragma unroll
    for (int j = 0; j < 8; ++j) ss += (v[j][0] * v[j][0] + v[j][1] * v[j][1]) + (v[j][2] * v[j][2] + v[j][3] * v[j][3]);
    const float rstd = 1.0f / sqrtf(wave_sum(ss) * (1.0f / DM) + EPS);
#pragma unroll
    for (int j = 0; j < 8; ++j) { v[j] = v[j] * rstd * gs[j] + sh[j];
        u32x2 w; w.x = cvtpk(v[j][0], v[j][1]); w.y = cvtpk(v[j][2], v[j][3]);
        *(u32x2*)(hrow + 4 * lane + 256 * j) = w; }
    if constexpr (FGATE) {
        f32x4 fa = {0.f, 0.f, 0.f, 0.f}, fb = {0.f, 0.f, 0.f, 0.f};
#pragma unroll
        for (int j = 0; j < 8; ++j)
#pragma unroll
            for (int e = 0; e < 4; ++e) { const f32x4 a = wfA[(j * 4 + e) * 64 + lane], b = wfB[(j * 4 + e) * 64 + lane]; fa += a * v[j][e]; fb += b * v[j][e]; }
        float z[8];
#pragma unroll
        for (int e = 0; e < 4; ++e) { z[e] = wave_sum(fa[e]); z[4 + e] = wave_sum(fb[e]); }
        float zz = z[0];
#pragma unroll
        for (int e = 1; e < 8; ++e) zz = (lane == e) ? z[e] : zz;
        if (lane < 8) { zz += bf[lane]; const float lf = fminf(zz, 0.f) - log1pf(expf(-fabsf(zz))); fout[lane] = lf; }
    }
}
template <bool FGATE>
__device__ __forceinline__ void norm_phase(const float* xp32, const float* xs32, bf16_t* xb, const float* g, const float* mods_l, int chunk, bf16_t* H,
                                           const float* wf_src, const float* bf, float* out, const SampleFix fx, LAS unsigned char* lds, int G, int wg, int tid, int wave, int lane) {
    const LAS f32x4* wfA = (const LAS f32x4*)lds; const LAS f32x4* wfB = (const LAS f32x4*)(lds + 32768);
    if constexpr (FGATE) {
        for (int c = tid; c < DM; c += 512) { const int j = c >> 8, ln = (c & 255) >> 2, e = c & 3, idx = (j * 4 + e) * 64 + ln;
            const float* s = wf_src + (size_t)c * LD_WINAB + 6144;
            ((LAS f32x4*)lds)[idx] = *(const f32x4*)s; ((LAS f32x4*)(lds + 32768))[idx] = *(const f32x4*)(s + 4); }
        __syncthreads();
    }
    f32x4 gs[8], sh[8], v[8], v2[8];
    for (int blk = wg; blk < 256; blk += G) {
        const int b = blk >> 5, r0 = b * SEQ + (blk & 31) * 128 + wave * 16;
        const float* shp = mods_l + (size_t)b * NADA + chunk * DM; const float* scp = shp + DM;
#pragma unroll
        for (int j = 0; j < 8; ++j) { const int c = 4 * lane + 256 * j; gs[j] = *(const f32x4*)(g + c) * (*(const f32x4*)(scp + c) + 1.0f); sh[j] = *(const f32x4*)(shp + c); }
        for (int i = 0; i < 16; i += 2) { const int row = r0 + i;
            load_row(v, xp32 ? xp32 + (size_t)row * DM : nullptr, xb + (size_t)row * DM, lane);
            load_row(v2, xp32 ? xp32 + (size_t)(row + 1) * DM : nullptr, xb + (size_t)(row + 1) * DM, lane);
            norm_row<FGATE>(v, H + (size_t)row * DM, gs, sh, lane, wfA, wfB, bf, FGATE ? out + OFF_BFP + (size_t)row * 8 : nullptr);
            norm_row<FGATE>(v2, H + (size_t)(row + 1) * DM, gs, sh, lane, wfA, wfB, bf, FGATE ? out + OFF_BFP + (size_t)(row + 1) * 8 : nullptr); }
    }
    for (int s = wave * G + wg; s < MS; s += 8 * G) {
        const int mr = 8 + (s >> 6);
        const float* shp = mods_l + (size_t)mr * NADA + chunk * DM; const float* scp = shp + DM;
#pragma unroll
        for (int j = 0; j < 8; ++j) { const int c = 4 * lane + 256 * j; gs[j] = *(const f32x4*)(g + c) * (*(const f32x4*)(scp + c) + 1.0f); sh[j] = *(const f32x4*)(shp + c); }
        load_row(v, xs32 ? xs32 + (size_t)s * DM : nullptr, xb + (size_t)(MP + s) * DM, lane);
        if (fx.S) sample_fix(v, fx, s, xb + (size_t)(MP + s) * DM, lane);
        norm_row<FGATE>(v, H + (size_t)(MP + s) * DM, gs, sh, lane, wfA, wfB, bf, FGATE ? out + OFF_BFS + (size_t)s * 8 : nullptr);
    }
}
__device__ __forceinline__ void final_norm_phase(bf16_t* xb, float* y, const float* g, const SampleFix fx, int G, int wg, int wave, int lane) {
    f32x4 gv[8], v[8], v2[8];
#pragma unroll
    for (int j = 0; j < 8; ++j) gv[j] = *(const f32x4*)(g + 4 * lane + 256 * j);
#define FN_ROW(V, ROW) do { float ss = 0.f; _Pragma("unroll") for (int j = 0; j < 8; ++j) ss += (V[j][0] * V[j][0] + V[j][1] * V[j][1]) + (V[j][2] * V[j][2] + V[j][3] * V[j][3]); \
        const float rstd = 1.0f / sqrtf(wave_sum(ss) * (1.0f / DM) + EPS); float* yr = y + (size_t)(ROW) * DM; \
        _Pragma("unroll") for (int j = 0; j < 8; ++j) __builtin_nontemporal_store(V[j] * rstd * gv[j], (f32x4*)(yr + 4 * lane + 256 * j)); } while (0)
    for (int row = (wg * 8 + wave) * 2; row < MP; row += G * 16) {
        load_row(v, nullptr, xb + (size_t)row * DM, lane); load_row(v2, nullptr, xb + (size_t)(row + 1) * DM, lane);
        FN_ROW(v, row); FN_ROW(v2, row + 1);
    }
    for (int s = wave * G + wg; s < MS; s += 8 * G) {
        load_row(v, nullptr, xb + (size_t)(MP + s) * DM, lane);
        if (fx.S) sample_fix(v, fx, s, xb + (size_t)(MP + s) * DM, lane);
        FN_ROW(v, MP + s);
    }
#undef FN_ROW
}

__device__ __forceinline__ void cumsum_seq(const float* s1, int n1, const float* s2, int n2, float* dst, LAS unsigned char* lds, int tid, int wave, int lane) {
    LAS double* red = (LAS double*)lds;
    const int n = n1 + n2;
    double loc[9]; double run = 0.0;
#pragma unroll
    for (int e = 0; e < 9; ++e) { const int pos = 9 * tid + e; float v = 0.f;
        if (pos < n) v = (pos < n1) ? s1[(size_t)pos * 8] : s2[(size_t)(pos - n1) * 8];
        run += (double)v; loc[e] = run; }
    double x = run;
#pragma unroll
    for (int o = 1; o < 64; o <<= 1) { const double y = __shfl_up(x, o); if (lane >= o) x += y; }
    __syncthreads();
    if (lane == 63) red[wave] = x;
    __syncthreads();
    double pre = x - run;
    for (int w = 0; w < wave; ++w) pre += red[w];
#pragma unroll
    for (int e = 0; e < 9; ++e) { const int pos = 9 * tid + e; if (pos < n) dst[pos] = (float)((pre + loc[e]) * 1.4426950408889634); }
    __syncthreads();
}

namespace att {
constexpr int SHM = 16384;
constexpr int L_V = 0, L_K = 2 * SHM, L_WS = 4 * SHM, L_TAB = L_WS + 2048, L_FK = L_TAB + 1024, L_ACT = L_FK + 512, L_END = L_ACT + 64;
constexpr float THR2 = 11.0f;
#define KSWZ(row, colB) ((row) * 256 + ((colB) ^ (((row) & 7) << 4)))
__device__ __forceinline__ int v_st(int k, int c) { const int kk = (k & ~0xC) | ((k & 4) << 1) | ((k & 8) >> 1); return ((kk >> 3) * 4 + (c >> 5)) * 512 + ((kk & 7) * 32 + (c & 31)) * 2; }
__device__ __forceinline__ int v_rd_base(int lane) { return ((lane & 3) << 3) | (((lane >> 2) & 3) << 6) | (((lane >> 4) & 1) << 5) | (((lane >> 5) & 1) << 8); }
__device__ __forceinline__ int crow(int r, int hi) { return (r & 3) + 8 * (r >> 2) + 4 * hi; }

struct Args {
    const void* K1; const void* V1; const void* K2; const void* V2;
    const bf16_t* Q; bf16_t* O;
    const float* F;
    const float* tabsrc; int tabkind;
    float* o1s; const float* subg; float lam; float kmax2;
    int ks, qs, os, nrows, qpos0, kpos0, nt, tsplit, band;
};

template <int ND0, bool K128P = false>
__device__ __forceinline__ void qkt(f32x16& p0, f32x16& p1, const f32x16& c0, const f32x16& c1, const LAS unsigned char* Kt, int r32, int hi, const bf16x8 (&qr)[ND0]) {
    p0 = c0; p1 = c1;
    const LAS unsigned char* kb[4];
#pragma unroll
    for (int dd = 0; dd < 4; ++dd) kb[dd] = K128P ? Kt + r32 * 128 + (((dd * 2 + hi) ^ ((r32 >> 1) & 7)) << 4) : Kt + KSWZ(r32, (dd * 16 + hi * 8) * 2);
#pragma unroll
    for (int d0 = 0; d0 < ND0; ++d0) { const LAS unsigned char* a = kb[d0 & 3] + (d0 >> 2) * 128;
        const bf16x8 b0 = *(const LAS bf16x8*)a;
        const bf16x8 b1 = *(const LAS bf16x8*)(a + 32 * (K128P ? 128 : 256));
        p0 = __builtin_amdgcn_mfma_f32_32x32x16_bf16(b0, qr[d0], p0, 0, 0, 0);
        p1 = __builtin_amdgcn_mfma_f32_32x32x16_bf16(b1, qr[d0], p1, 0, 0, 0); }
}
#define TRRD(p) __builtin_amdgcn_ds_read_tr16_b64_v4i16((LAS s16x4*)(p))
__device__ __forceinline__ void pv_tile(f32x16 (&o)[4], const LAS unsigned char* vb, bf16x8 pa0, bf16x8 pa1, bf16x8 pa2, bf16x8 pa3) {
    s16x4 la[4], ha[4], lb[4], hb[4];
#define PV_RD(L, H, ks) _Pragma("unroll") for (int d0 = 0; d0 < 4; ++d0) { L[d0] = TRRD(vb + d0 * 512 + (ks) * 4096); H[d0] = TRRD(vb + d0 * 512 + (ks) * 4096 + 2048); }
#define PV_MM(L, H, pa) _Pragma("unroll") for (int d0 = 0; d0 < 4; ++d0) o[d0] = __builtin_amdgcn_mfma_f32_32x32x16_bf16((bf16x8){L[d0][0], L[d0][1], L[d0][2], L[d0][3], H[d0][0], H[d0][1], H[d0][2], H[d0][3]}, pa, o[d0], 0, 0, 0);
    PV_RD(la, ha, 0) SBAR();
    PV_RD(lb, hb, 1) PV_MM(la, ha, pa0) SBAR();
    PV_RD(la, ha, 2) PV_MM(lb, hb, pa1) SBAR();
    PV_RD(lb, hb, 3) PV_MM(la, ha, pa2) SBAR();
    PV_MM(lb, hb, pa3) SBAR();
#undef PV_RD
#undef PV_MM
}
__device__ __forceinline__ int t5_bucket(int rel) {
    const int n = rel < 0 ? -rel : rel; int b;
    if (n < 8) b = n; else if (n < 12) b = 8; else if (n < 16) b = 9; else if (n < 23) b = 10; else if (n < 32) b = 11; else if (n < 46) b = 12; else if (n < 64) b = 13; else if (n < 91) b = 14; else b = 15;
    return b + (rel > 0 ? 16 : 0);
}

template <bool F32SRC, int DQK, int MODE, bool PRUNE = false>
__device__ __forceinline__ void attn_item(LAS unsigned char* lds, const Args& a, int wave_s) {
    constexpr bool DUAL = F32SRC && DQK == 64;
    constexpr int ND0 = DQK / 16, NPASS = (DQK == 64 && !DUAL) ? 2 : 1;
    constexpr bool KHALF = !F32SRC && DQK == 64;
    const int tid = fresh_tid(wave_s), wave = __builtin_amdgcn_readfirstlane(tid >> 6), lane = tid & 63, r32 = lane & 31, hi = lane >> 5;
    LAS unsigned char* V_lds = lds + L_V; LAS unsigned char* K_lds = lds + L_K;
    LAS float* li_l = (LAS float*)(lds + L_WS) + wave * 64; LAS float* al_l = li_l + 32;
    LAS float* tab = (LAS float*)(lds + L_TAB); LAS float* fk = (LAS float*)(lds + L_FK);
    const int rg = DUAL ? (wave & 1) : wave, hfw = DUAL ? (wave >> 1) : 0;
    const bool wact = DUAL ? (wave < 4) : (wave * 32 < a.nrows);
    const int wq0 = a.qpos0 + rg * 32, cq = wq0 >> 6, qpos = wq0 + r32;
    const int sr = tid >> 4, sc = (tid & 15) * 8;
    const int kws = KSWZ(sr, sc * 2), vst0 = v_st(sr, sc), vst1 = v_st(32 + sr, sc);
    const LAS unsigned char* vb = V_lds + v_rd_base(lane);
    bf16x8 sk0, sk1, sv0, sv1; f32x4 fk0a, fk0b, fk1a, fk1b, fv0a, fv0b, fv1a, fv1b; float ff = 0.f;
    int vdo[2] = {0, 0}, kdo = 0;
    if constexpr (KHALF) {
#pragma unroll
        for (int j = 0; j < 2; ++j) { const int P = (wave * 2 + j) * 64 + lane; const int kk = ((P >> 7) << 3) | ((P >> 2) & 7), kr = (kk & ~0xC) | ((kk & 4) << 1) | ((kk & 8) >> 1), c = ((P >> 5) & 3) * 32 + (P & 3) * 8; vdo[j] = kr * a.ks + c; }
        { const int P = wave * 64 + lane, r = P >> 3, c = (P & 7) ^ ((r >> 1) & 7); kdo = r * a.ks + c * 8; }
    }
#define AT_LOAD(t) do { const int t_ = (t); const bool s2_ = t_ >= a.tsplit; const size_t ro_ = (size_t)((s2_ ? t_ - a.tsplit : t_) * 64 + sr) * a.ks + sc; const size_t r32o_ = (size_t)32 * a.ks; \
        if constexpr (F32SRC) { const float* kp_ = (const float*)(s2_ ? a.K2 : a.K1) + ro_; const float* vp_ = (const float*)(s2_ ? a.V2 : a.V1) + ro_; \
            fv0a = *(const f32x4*)vp_; fv0b = *(const f32x4*)(vp_ + 4); fv1a = *(const f32x4*)(vp_ + r32o_); fv1b = *(const f32x4*)(vp_ + r32o_ + 4); \
            fk0a = *(const f32x4*)kp_; fk0b = *(const f32x4*)(kp_ + 4); fk1a = *(const f32x4*)(kp_ + r32o_); fk1b = *(const f32x4*)(kp_ + r32o_ + 4); } \
        else if constexpr (KHALF) { } \
        else { const bf16_t* kp_ = (const bf16_t*)(s2_ ? a.K2 : a.K1) + ro_; const bf16_t* vp_ = (const bf16_t*)(s2_ ? a.V2 : a.V1) + ro_; \
            sv0 = *(const bf16x8*)vp_; sv1 = *(const bf16x8*)(vp_ + r32o_); sk0 = *(const bf16x8*)kp_; sk1 = *(const bf16x8*)(kp_ + r32o_); } \
        if constexpr (MODE == 1) { if (tid < 64) ff = a.F[t_ * 64 + tid]; } } while (0)
#define AT_VDMA(t, bf) do { if constexpr (KHALF) { const int t_ = (t); const bool s2_ = t_ >= a.tsplit; const bf16_t* vb_ = (const bf16_t*)(s2_ ? a.V2 : a.V1) + (size_t)((s2_ ? t_ - a.tsplit : t_) * 64) * a.ks; \
        _Pragma("unroll") for (int j_ = 0; j_ < 2; ++j_) __builtin_amdgcn_global_load_lds((const unsigned*)(vb_ + vdo[j_]), (LAS unsigned*)(V_lds + (bf) * SHM + (wave * 2 + j_) * 1024), 16, 0, 0); \
        const bf16_t* kb_ = (const bf16_t*)(s2_ ? a.K2 : a.K1) + (size_t)((s2_ ? t_ - a.tsplit : t_) * 64) * a.ks + pass * 64; \
        __builtin_amdgcn_global_load_lds((const unsigned*)(kb_ + kdo), (LAS unsigned*)(K_lds + (bf) * SHM + wave * 1024), 16, 0, 0); } } while (0)
#define AT_WRITE(bf) do { const int b_ = (bf); \
        if constexpr (F32SRC) { sk0 = pack8(fk0a, fk0b); sk1 = pack8(fk1a, fk1b); sv0 = pack8(fv0a, fv0b); sv1 = pack8(fv1a, fv1b); } \
        if constexpr (KHALF) { } \
        else { *(LAS bf16x8*)(K_lds + b_ * SHM + kws) = sk0; *(LAS bf16x8*)(K_lds + b_ * SHM + kws + 32 * 256) = sk1; } \
        if constexpr (!KHALF) { *(LAS bf16x8*)(V_lds + b_ * SHM + vst0) = sv0; *(LAS bf16x8*)(V_lds + b_ * SHM + vst1) = sv1; } \
        if constexpr (MODE == 1) { if (tid < 64) fk[b_ * 64 + tid] = -ff; } } while (0)

    for (int pass = 0; pass < NPASS; ++pass) {
        bf16x8 qr[ND0];
#pragma unroll
        for (int d0 = 0; d0 < ND0; ++d0) qr[d0] = wact ? *(const bf16x8*)(a.Q + (size_t)(rg * 32 + r32) * a.qs + (DUAL ? hfw : pass) * 64 + d0 * 16 + hi * 8) : bf16x8{};
        float m_reg = -1e30f, l_reg = 0.f; f32x16 o[4];
#pragma unroll
        for (int d0 = 0; d0 < 4; ++d0) o[d0] = f32x16{};
        f32x16 cfar = f32x16{}; bool cdirty = true;
        float sbound = 0.f; bool wdone = false;
        if constexpr (PRUNE) {
            float qq = 0.f;
#pragma unroll
            for (int d0 = 0; d0 < ND0; ++d0)
#pragma unroll
                for (int e = 0; e < 8; ++e) { const float x = __uint_as_float(((unsigned)(unsigned short)qr[d0][e]) << 16); qq += x * x; }
            { auto rr = __builtin_amdgcn_permlane32_swap(__float_as_uint(qq), __float_as_uint(qq), false, false); qq = __uint_as_float(rr[0]) + __uint_as_float(rr[1]); }
#pragma unroll
            for (int x = 1; x < 32; x <<= 1) qq = fmaxf(qq, __shfl_xor(qq, x));
            sbound = sqrtf(qq * a.kmax2) * 1.02f + 0.5f;
            LAS int* actf = (LAS int*)(lds + L_ACT);
            if (tid < 16) actf[tid] = 0;
        }
#define AT_TILE(i_) (PRUNE ? (a.nt - 1 - (i_)) : (i_))
        AT_LOAD(AT_TILE(0)); AT_VDMA(AT_TILE(0), 0);
        if constexpr (MODE == 0) {
            if (pass == 0 && tid < 256) { int rel = tid - 192; if (rel < -128) rel = -128; float v;
                if (a.tabkind == 0) v = a.tabsrc[t5_bucket(rel) * 8]; else v = a.tabsrc[(rel + 128) * 16];
                tab[tid] = v * LOG2E; }
        }
        AT_WRITE(0);
        __syncthreads();
        if (wave >= 4) __builtin_amdgcn_s_setprio(1);
        for (int it = 0; it < a.nt; ++it) {
            const int buf = it & 1, t = AT_TILE(it);
            if (it + 1 < a.nt) { AT_LOAD(AT_TILE(it + 1)); AT_VDMA(AT_TILE(it + 1), buf ^ 1); }
            SBAR();
            const int kb = a.kpos0 + 64 * t;
            bool act;
            if constexpr (MODE == 0) { const int kc = kb >> 6; act = wact && (kc <= cq) && (kc >= cq - a.band); }
            else act = wact && (kb <= wq0 + 31);
            if constexpr (PRUNE) {
                if (act && !wdone) {
                    float mm = m_reg;
#pragma unroll
                    for (int x = 1; x < 32; x <<= 1) mm = fminf(mm, __shfl_xor(mm, x));
                    const float btile = fk[buf * 64 + 63];
                    if (__all(mm > -1e29f && sbound + btile - mm < -40.0f)) wdone = true;
                }
                act = act && !wdone;
            }
            if (act) {
                f32x16 p0, p1; float alpha = 1.f, ps = 0.f;
                if constexpr (F32SRC) {
                                { const f32x16 z = f32x16{}; qkt<ND0>(p0, p1, z, z, K_lds + buf * SHM + (DUAL ? hfw : pass) * 128, r32, hi, qr); }
                float cb = 0.f;
                if constexpr (MODE == 0) {
                    if (kb - wq0 + 191 <= 0) cb = tab[0];
                    else { const LAS float* tp = tab + (kb - qpos + 4 * hi + 192);
#pragma unroll
                        for (int r = 0; r < 16; ++r) { const int c = (r & 3) + 8 * (r >> 2); p0[r] += tp[c]; p1[r] += tp[c + 32]; } }
                } else {
                    const LAS f32x4* f4 = (const LAS f32x4*)(fk + buf * 64);
#pragma unroll
                    for (int j = 0; j < 4; ++j) { const f32x4 fa = f4[2 * j + hi], fb = f4[8 + 2 * j + hi];
#pragma unroll
                        for (int e = 0; e < 4; ++e) { p0[4 * j + e] += fa[e]; p1[4 * j + e] += fb[e]; } }
                    if (kb + 63 > wq0) { const int dq = qpos - kb - 4 * hi; const float NEG = -__builtin_inff();
#pragma unroll
                        for (int r = 0; r < 16; ++r) { const int c = (r & 3) + 8 * (r >> 2); if (c > dq) p0[r] = NEG; if (c + 32 > dq) p1[r] = NEG; } }
                }
                float pmax = p0[0];
#pragma unroll
                for (int r = 1; r < 16; ++r) pmax = fmaxf(pmax, p0[r]);
#pragma unroll
                for (int r = 0; r < 16; ++r) pmax = fmaxf(pmax, p1[r]);
                { auto rr = __builtin_amdgcn_permlane32_swap(__float_as_uint(pmax), __float_as_uint(pmax), false, false);
                  pmax = fmaxf(__uint_as_float(rr[0]), __uint_as_float(rr[1])) + cb; }
                float mn;
                if (__all((pmax - m_reg) <= THR2)) { mn = m_reg; }
                else { mn = fmaxf(m_reg, pmax); alpha = __builtin_amdgcn_exp2f(m_reg - mn); m_reg = mn; }
                const float mnc = mn - cb;
#pragma unroll
                for (int r = 0; r < 16; ++r) { p0[r] = __builtin_amdgcn_exp2f(p0[r] - mnc); p1[r] = __builtin_amdgcn_exp2f(p1[r] - mnc); ps += p0[r] + p1[r]; }
                { auto rr = __builtin_amdgcn_permlane32_swap(__float_as_uint(ps), __float_as_uint(ps), false, false);
                  ps = __uint_as_float(rr[0]) + __uint_as_float(rr[1]); }
                } else {
                const bool fl = m_reg < -1e29f; const float mref = fl ? 0.f : m_reg;
#define AT_BIAS(D0, D1, OP) do { \
                if constexpr (MODE == 0) { \
                    if (kb - wq0 + 191 <= 0) { const float nb = tab[0] - mref; \
                        _Pragma("unroll") for (int r = 0; r < 16; ++r) { D0[r] OP nb; D1[r] OP nb; } } \
                    else { const LAS float* tp = tab + (kb - qpos + 4 * hi + 192); \
                        _Pragma("unroll") for (int r = 0; r < 16; ++r) { const int c = (r & 3) + 8 * (r >> 2); D0[r] OP tp[c] - mref; D1[r] OP tp[c + 32] - mref; } } \
                } else { \
                    const LAS f32x4* f4 = (const LAS f32x4*)(fk + buf * 64); \
                    _Pragma("unroll") for (int j = 0; j < 4; ++j) { const f32x4 fa = f4[2 * j + hi], fb = f4[8 + 2 * j + hi]; \
                        _Pragma("unroll") for (int e = 0; e < 4; ++e) { D0[4 * j + e] OP fa[e] - mref; D1[4 * j + e] OP fb[e] - mref; } } \
                } } while (0)
                if (MODE == 0 && kb - wq0 + 191 <= 0) {
                    if constexpr (KHALF) {
                        if (cdirty) { const float nb = tab[0] - mref;
#pragma unroll
                            for (int r = 0; r < 16; ++r) cfar[r] = nb;
                            cdirty = false; }
                        qkt<ND0, KHALF>(p0, p1, cfar, cfar, K_lds + buf * SHM, r32, hi, qr);
                    } else {
                    f32x16 c; const float nb = tab[0] - mref;
#pragma unroll
                    for (int r = 0; r < 16; ++r) c[r] = nb;
                    qkt<ND0, KHALF>(p0, p1, c, c, K_lds + buf * SHM + (KHALF ? 0 : (DUAL ? hfw : pass) * 128), r32, hi, qr); }
                } else { f32x16 c0, c1; AT_BIAS(c0, c1, =); qkt<ND0, KHALF>(p0, p1, c0, c1, K_lds + buf * SHM + (KHALF ? 0 : (DUAL ? hfw : pass) * 128), r32, hi, qr); }
#undef AT_BIAS
                if constexpr (MODE == 1) {
                    if (kb + 63 > wq0) { const int dq = qpos - kb - 4 * hi; const float NEG = -__builtin_inff();
#pragma unroll
                        for (int r = 0; r < 16; ++r) { const int c = (r & 3) + 8 * (r >> 2); if (c > dq) p0[r] = NEG; if (c + 32 > dq) p1[r] = NEG; } }
                }
                float pmax = p0[0];
#pragma unroll
                for (int r = 1; r < 16; ++r) pmax = fmaxf(pmax, p0[r]);
#pragma unroll
                for (int r = 0; r < 16; ++r) pmax = fmaxf(pmax, p1[r]);
                float d = 0.f;
                const bool common = __all(!fl && pmax <= THR2);
                if (!common) { { auto rr = __builtin_amdgcn_permlane32_swap(__float_as_uint(pmax), __float_as_uint(pmax), false, false);
                                 pmax = fmaxf(__uint_as_float(rr[0]), __uint_as_float(rr[1])); }
                    d = fl ? fmaxf(pmax, -1e30f) : fmaxf(pmax, 0.f); alpha = fl ? 1.f : __builtin_amdgcn_exp2f(-d); m_reg = mref + d; cdirty = true; }
                if (common) {
#pragma unroll
                    for (int r = 0; r < 16; ++r) { p0[r] = __builtin_amdgcn_exp2f(p0[r]); p1[r] = __builtin_amdgcn_exp2f(p1[r]); ps += p0[r] + p1[r]; }
                } else {
#pragma unroll
                    for (int r = 0; r < 16; ++r) { p0[r] = __builtin_amdgcn_exp2f(p0[r] - d); p1[r] = __builtin_amdgcn_exp2f(p1[r] - d); ps += p0[r] + p1[r]; }
                }
                }
                l_reg = l_reg * alpha + ps;
                bf16x8 pa0, pa1, pa2, pa3;
#define PK4(P, B_, OUT) do { unsigned a0 = cvtpk(P[B_+0], P[B_+1]), a1 = cvtpk(P[B_+2], P[B_+3]); \
        unsigned b0 = cvtpk(P[B_+4], P[B_+5]), b1 = cvtpk(P[B_+6], P[B_+7]); \
        auto r0 = __builtin_amdgcn_permlane32_swap(a0, b0, false, false); auto r1 = __builtin_amdgcn_permlane32_swap(a1, b1, false, false); \
        u32x4 w = {r0[0], r1[0], r0[1], r1[1]}; OUT = *reinterpret_cast<bf16x8*>(&w); } while (0)
                PK4(p0, 0, pa0); PK4(p0, 8, pa1); PK4(p1, 0, pa2); PK4(p1, 8, pa3);
#undef PK4
                if (__any(alpha < 1.f)) {
#pragma unroll
                    for (int d0 = 0; d0 < 4; ++d0)
#pragma unroll
                        for (int r = 0; r < 16; ++r) o[d0][r] *= alpha; }
                pv_tile(o, vb + buf * SHM, pa0, pa1, pa2, pa3);
            }
            SBAR();
            if (it + 1 < a.nt) AT_WRITE(buf ^ 1);
            if constexpr (PRUNE) { if (lane == 0) ((LAS int*)(lds + L_ACT))[buf * 8 + wave] = (wact && !wdone) ? 1 : 0; }
            __syncthreads();
            if constexpr (PRUNE) { const LAS int* af = (const LAS int*)(lds + L_ACT) + buf * 8; int any = 0;
#pragma unroll
                for (int w = 0; w < 8; ++w) any |= af[w];
                if (!any) break; }
        }
#undef AT_TILE
        __builtin_amdgcn_s_setprio(0);
        if constexpr (!F32SRC) { auto rr = __builtin_amdgcn_permlane32_swap(__float_as_uint(l_reg), __float_as_uint(l_reg), false, false); l_reg = __uint_as_float(rr[0]) + __uint_as_float(rr[1]); }
        const float rl = __builtin_amdgcn_rcpf(l_reg);
#define AT_STORE_ROW(OROW, VAL) do { _Pragma("unroll") for (int d0 = 0; d0 < 4; ++d0) _Pragma("unroll") for (int k = 0; k < 2; ++k) { \
            unsigned x0 = cvtpk(VAL(d0, 8 * k + 0), VAL(d0, 8 * k + 1)), x1 = cvtpk(VAL(d0, 8 * k + 2), VAL(d0, 8 * k + 3)); \
            unsigned y0 = cvtpk(VAL(d0, 8 * k + 4), VAL(d0, 8 * k + 5)), y1 = cvtpk(VAL(d0, 8 * k + 6), VAL(d0, 8 * k + 7)); \
            auto s0 = __builtin_amdgcn_permlane32_swap(x0, y0, false, false); auto s1 = __builtin_amdgcn_permlane32_swap(x1, y1, false, false); \
            u32x4 w = {s0[0], s1[0], s0[1], s1[1]}; \
            int oo = d0 * 32 + 16 * k + 8 * hi; asm volatile("" : "+v"(oo)); \
            *(u32x4*)((OROW) + oo) = w; } } while (0)
        if constexpr (DUAL) {
            LAS float* X = (LAS float*)(lds + 73728);
            if (wact && hfw == 1) {
#pragma unroll
                for (int r = 0; r < 16; ++r)
#pragma unroll
                    for (int d0 = 0; d0 < 4; ++d0) X[(rg * 64 + r * 4 + d0) * 64 + lane] = o[d0][r] * rl;
            }
            __syncthreads();
            if (wact && hfw == 0) {
                float ssq = 0.f;
#pragma unroll
                for (int r = 0; r < 16; ++r)
#pragma unroll
                    for (int d0 = 0; d0 < 4; ++d0) { const float v = o[d0][r] * rl - a.lam * X[(rg * 64 + r * 4 + d0) * 64 + lane]; o[d0][r] = v; ssq += v * v; }
                { auto rr = __builtin_amdgcn_permlane32_swap(__float_as_uint(ssq), __float_as_uint(ssq), false, false); ssq = __uint_as_float(rr[0]) + __uint_as_float(rr[1]); }
                const float rs = 0.8f * __builtin_amdgcn_rsqf(ssq * (1.0f / 128.0f) + EPS);
                bf16_t* orow = a.O + (size_t)(rg * 32 + r32) * a.os;
                const float* gp = a.subg + 4 * hi;
#pragma unroll
                for (int d0 = 0; d0 < 4; ++d0)
#pragma unroll
                    for (int g = 0; g < 4; ++g) { const f32x4 gg = *(const f32x4*)(gp + d0 * 32 + 8 * g);
#pragma unroll
                        for (int e = 0; e < 4; ++e) o[d0][4 * g + e] *= rs * gg[e]; }
#define AT_VAL(d0_, r_) o[d0_][r_]
                AT_STORE_ROW(orow, AT_VAL);
#undef AT_VAL
            }
        } else
        if (wact) {
            if (DQK == 64 && pass == 0) {
#pragma unroll
                for (int r = 0; r < 16; ++r) {
                    int so = wave * 4096 + r * 256 + lane; asm volatile("" : "+v"(so));
                    float* sp = a.o1s + so;
#pragma unroll
                    for (int d0 = 0; d0 < 4; ++d0) sp[d0 * 64] = o[d0][r] * rl; }
                VM_WAIT();
            } else {
                bf16_t* orow = a.O + (size_t)(wave * 32 + r32) * a.os;
                if constexpr (DQK == 64) {
                    float ssq = 0.f;
#pragma unroll
                    for (int r = 0; r < 16; ++r) {
                        int so = wave * 4096 + r * 256 + lane; asm volatile("" : "+v"(so));
                        const float* sp = a.o1s + so;
#pragma unroll
                        for (int d0 = 0; d0 < 4; ++d0) { const float o1 = __hip_atomic_load(sp + d0 * 64, __ATOMIC_RELAXED, __HIP_MEMORY_SCOPE_AGENT);
                            const float v = o1 - a.lam * (o[d0][r] * rl); o[d0][r] = v; ssq += v * v; } }
                    { auto rr = __builtin_amdgcn_permlane32_swap(__float_as_uint(ssq), __float_as_uint(ssq), false, false); ssq = __uint_as_float(rr[0]) + __uint_as_float(rr[1]); }
                    const float rs = 0.8f * __builtin_amdgcn_rsqf(ssq * (1.0f / 128.0f) + EPS);
                    const float* gp = a.subg + 4 * hi;
#pragma unroll
                    for (int d0 = 0; d0 < 4; ++d0)
#pragma unroll
                        for (int g = 0; g < 4; ++g) { const f32x4 gg = *(const f32x4*)(gp + d0 * 32 + 8 * g);
#pragma unroll
                            for (int e = 0; e < 4; ++e) o[d0][4 * g + e] *= rs * gg[e]; }
                } else {
#pragma unroll
                    for (int d0 = 0; d0 < 4; ++d0)
#pragma unroll
                        for (int r = 0; r < 16; ++r) o[d0][r] *= rl;
                }
#define AT_VAL(d0_, r_) o[d0_][r_]
                AT_STORE_ROW(orow, AT_VAL);
#undef AT_VAL
            }
        }
#undef AT_STORE_ROW
        __syncthreads();
    }
#undef AT_LOAD
#undef AT_WRITE
#undef AT_VDMA
}
}

struct KArgs { InPtrs in; float* out; unsigned char* ws; int ph_lo, ph_hi; };

#define Q_PRE() unsigned nx_ = 0u; if (tid == 0) nx_ = __hip_atomic_fetch_add(qw, 1u, __ATOMIC_RELAXED, __HIP_MEMORY_SCOPE_AGENT)
__device__ __forceinline__ int q_post(unsigned nx, volatile LAS unsigned* slot, int tid) {
    if (tid == 0) *slot = nx;
    __syncthreads();
    return (int)*slot;
}
__device__ __forceinline__ int q_next(unsigned* qw, volatile LAS unsigned* slot, int tid) {
    __syncthreads();
    if (tid == 0) *slot = __hip_atomic_fetch_add(qw, 1u, __ATOMIC_RELAXED, __HIP_MEMORY_SCOPE_AGENT);
    __syncthreads();
    return (int)*slot;
}

__device__ __forceinline__ void sample_qkv_finalize(const float* part, int b, int colq, int colk, int colv, float qscale, bf16_t* BIG, float* outK, float* outV, int ldf, int hcol, int tid) {
    for (int i = tid; i < 3 * 64 * 16; i += 512) {
        const int sec3 = i >> 10, r = (i & 1023) >> 4, c8 = (i & 15) * 8;
        const int col = (sec3 == 0 ? colq : (sec3 == 1 ? colk : colv)) + c8;
        const float* pp = part + ((size_t)(b * 64 + r)) * NQKV + col;
        f32x4 s0 = {0.f, 0.f, 0.f, 0.f}, s1 = {0.f, 0.f, 0.f, 0.f};
#pragma unroll
        for (int sl = 0; sl < 5; ++sl) { s0 += *(const f32x4*)(pp + (size_t)sl * MS * NQKV); s1 += *(const f32x4*)(pp + (size_t)sl * MS * NQKV + 4); }
        if (sec3 == 1) { float* d = outK + (size_t)(b * 64 + r) * ldf + hcol + c8; *(f32x4*)d = s0; *(f32x4*)(d + 4) = s1; }
        if (sec3 == 2) { float* d = outV + (size_t)(b * 64 + r) * ldf + hcol + c8; *(f32x4*)d = s0; *(f32x4*)(d + 4) = s1; }
        const float sc = sec3 == 0 ? qscale : 1.0f;
        u32x4 w; w.x = cvtpk(s0[0] * sc, s0[1] * sc); w.y = cvtpk(s0[2] * sc, s0[3] * sc); w.z = cvtpk(s1[0] * sc, s1[1] * sc); w.w = cvtpk(s1[2] * sc, s1[3] * sc);
        *(u32x4*)(BIG + (size_t)(MP + b * 64 + r) * NQKV + col) = w;
    }
    VM_WAIT(); __syncthreads();
}

template <int l>
__device__ __forceinline__ void layer_phases(LAS unsigned char* lds, unsigned char* ws, float* out, unsigned* ctl, const XcdBarrier& bar, int G, int wg, int wave0, int lo, int hi_, int& phase) {
    volatile LAS unsigned* MISC = (volatile LAS unsigned*)(lds + MISC_OFF);
    bf16_t* H = (bf16_t*)(ws + WS_H); bf16_t* BIG = (bf16_t*)(ws + WS_BIG); bf16_t* ATT = (bf16_t*)(ws + WS_ATT); bf16_t* XB = (bf16_t*)(ws + WS_XB);
    float* mods = (float*)(ws + WS_MODS);
#define PH_BEGIN if (phase >= lo && phase < hi_) { const int tid = fresh_tid(wave0), lane = tid & 63, wave = __builtin_amdgcn_readfirstlane(tid >> 6); (void)lane; (void)wave;
#define PH_END   if (MK_N_LAUNCHES == 1) xcd_barrier(bar, fresh_tid(wave0)); } ++phase;
#define MODS_L (mods + (size_t)l * 16 * NADA)
#define NG_L (inp(lds, 13) + (size_t)l * 3 * DM)
        PH_BEGIN { if (EN(2)) { norm_phase<false>((l == 0) ? inp(lds, 0) : nullptr, (l == 0) ? inp(lds, 1) : nullptr, XB, NG_L, MODS_L, 0, H, nullptr, nullptr, out, SampleFix{(const float*)(ws + WS_PART), (l == 0) ? 0 : 15, mods + 8 * DM, 0.5f}, lds, G, wg, tid, wave, lane); } } PH_END
        PH_BEGIN { pg8::Gemm g{H, (const bf16_t*)(ws + WS_WFI + (size_t)(l * 2 + 0) * SZ_WFI), MROWS, 11008, DM}; pg8::StaticOrder S; S.init(MROWS, 11008, G, wg); S.ntk = DM / 64;
            EpiSwiGLU E{BIG}; { if (EN(6)) { pg8::gemm_phase<EpiSwiGLU, pg8::StaticOrder, true, true>(lds, g, S, E, wave0); } } } PH_END
        PH_BEGIN { pg8::Gemm g{BIG, (const bf16_t*)(ws + WS_WFO + (size_t)(l * 2 + 0) * SZ_WFO), MROWS, DM, DFF}; pg8::SplitOrder S; S.init(DFF, DM, 15, G, wg);
            EpiResGate E{(l == 0) ? inp(lds, 0) : nullptr, XB, MODS_L + 2 * DM, 0.5f, (float*)(ws + WS_PART)}; { if (EN(7)) { pg8::gemm_phase<EpiResGate, pg8::SplitOrder, true, true>(lds, g, S, E, wave0); } } } PH_END
        PH_BEGIN if (l == 0) { if (EN(3)) { norm_phase<true>(nullptr, inp(lds, 1), XB, NG_L + DM, MODS_L, 3, H, inp(lds, 16), inp(lds, 17), out, SampleFix{(const float*)(ws + WS_PART), 15, MODS_L + 2 * DM, 0.5f}, lds, G, wg, tid, wave, lane); } }
                 else { if (EN(2)) { norm_phase<false>(nullptr, nullptr, XB, NG_L + DM, MODS_L, 3, H, nullptr, nullptr, out, SampleFix{(const float*)(ws + WS_PART), 15, MODS_L + 2 * DM, 0.5f}, lds, G, wg, tid, wave, lane); } } PH_END
        PH_BEGIN {
            if (l == 0 && wg < 128) {
                const int s = wg & 63, b = s >> 3, hh = s & 7;
                const bool smp = wg >= 64;
                const float* s1 = smp ? inp(lds, 6) + (size_t)b * PAST * 8 + hh : out + OFF_BFP + (size_t)b * SEQ * 8 + hh;
                const float* s2 = out + OFF_BFS + (size_t)b * DSEQ * 8 + hh;
                float* dst = smp ? (float*)(ws + WS_FS) + (size_t)s * (PAST + DSEQ) : (float*)(ws + WS_FP) + (size_t)s * SEQ;
                { if (EN(5)) { cumsum_seq(s1, SEQ, s2, smp ? DSEQ : 0, dst, lds, tid, wave, lane); } }
            }
            pg8::Gemm g{H, (const bf16_t*)(ws + (l == 0 ? WS_WINAB : WS_WINC)), MROWS, NQKV, DM}; pg8::SplitOrder S; S.init(DM, NQKV, 5, G, wg);
            EpiQKV E{BIG, out, l, (float*)(ws + WS_PART)};
            { if (EN(8)) { pg8::gemm_phase<EpiQKV, pg8::SplitOrder, true, true>(lds, g, S, E, wave0); } } } PH_END
        PH_BEGIN {
            att::Args a; a.o1s = (float*)(ws + WS_O1) + (size_t)wg * 32768; a.subg = inp(lds, 23); a.lam = 0.f; a.kmax2 = 0.f; a.F = nullptr; a.tabsrc = nullptr; a.tabkind = 0; a.band = 1 << 20;
            if (l == 0) {
                { float v1 = (lane < 64) ? inp(lds, 19)[lane] * inp(lds, 20)[lane] : 0.f, v2 = inp(lds, 21)[lane] * inp(lds, 22)[lane];
                  a.lam = expf(wave_sum(v1)) - expf(wave_sum(v2)) + 0.2f; }
                for (int u = wg; u < 256; u += G) {
                    const int s = u >> 2, b = s >> 3, h = s & 7;
                    const bf16_t* kp = BIG + (size_t)(b * SEQ + (u & 3) * 1024 + (tid >> 4)) * NQKV + 4096 + h * 128 + (tid & 15) * 8;
                    float mx = 0.f;
#pragma unroll 4
                    for (int i = 0; i < 32; ++i) { const bf16x8 v = *(const bf16x8*)(kp + (size_t)(32 * i) * NQKV); float ss = 0.f;
#pragma unroll
                        for (int e = 0; e < 8; ++e) { const float x = __uint_as_float(((unsigned)(unsigned short)v[e]) << 16); ss += x * x; }
                        ss += __shfl_xor(ss, 1); ss += __shfl_xor(ss, 2); ss += __shfl_xor(ss, 4); ss += __shfl_xor(ss, 8);
                        mx = fmaxf(mx, ss); }
                    mx = fmaxf(mx, __shfl_xor(mx, 16)); mx = fmaxf(mx, __shfl_xor(mx, 32));
                    if (lane == 0) __hip_atomic_fetch_max(ctl + CW_KMX + s, __float_as_uint(mx), __ATOMIC_RELAXED, __HIP_MEMORY_SCOPE_AGENT);
                }
                VM_WAIT(); __syncthreads();
                if (tid == 0) __hip_atomic_fetch_add(ctl + CW_KDONE, 1u, __ATOMIC_RELAXED, __HIP_MEMORY_SCOPE_AGENT);
                unsigned* qw = ctl + CW_Q0;
                int idx = q_next(qw, MISC + 12, tid);
                while (idx < 64) { Q_PRE(); const int b = idx >> 3, h = idx & 7;
                    a.K1 = inp(lds, 2) + ((size_t)b * PAST * 8 + h) * 128; a.V1 = inp(lds, 3) + ((size_t)b * PAST * 8 + h) * 128;
                    a.K2 = out + OFF_AKS + ((size_t)b * DSEQ * 8 + h) * 128; a.V2 = out + OFF_AVS + ((size_t)b * DSEQ * 8 + h) * 128; a.ks = 1024;
                    a.Q = BIG + (size_t)(MP + b * DSEQ) * NQKV + h * 128; a.qs = NQKV; a.O = ATT + (size_t)(MP + b * DSEQ) * DM + h * 128; a.os = DM;
                    a.nrows = 64; a.qpos0 = PAST; a.kpos0 = 0; a.nt = 65; a.tsplit = 64; a.tabsrc = inp(lds, 24) + h; a.tabkind = 0;
                    sample_qkv_finalize((const float*)(ws + WS_PART), b, h * 128, 1024 + h * 128, 2048 + h * 128, 1.0f, BIG, out + OFF_AKS, out + OFF_AVS, 1024, h * 128, tid);
                    { if (EN(9)) { att::attn_item<true, 64, 0>(lds, a, wave0); } } idx = q_post(nx_, MISC + 12 + (idx & 1), tid); }
                while (idx < 128) { Q_PRE(); const int s = idx - 64, b = s >> 3, h = s & 7;
                    a.K1 = inp(lds, 4) + ((size_t)b * PAST * 8 + h) * 128; a.V1 = inp(lds, 5) + ((size_t)b * PAST * 8 + h) * 128;
                    a.K2 = out + OFF_BKS + ((size_t)b * DSEQ * 8 + h) * 128; a.V2 = out + OFF_BVS + ((size_t)b * DSEQ * 8 + h) * 128; a.ks = 1024;
                    a.Q = BIG + (size_t)(MP + b * DSEQ) * NQKV + 3072 + h * 128; a.qs = NQKV; a.O = ATT + (size_t)(MP + b * DSEQ) * DM + 1024 + h * 128; a.os = DM;
                    a.nrows = 64; a.qpos0 = PAST; a.kpos0 = 0; a.nt = 65; a.tsplit = 64; a.F = (const float*)(ws + WS_FS) + (size_t)s * (PAST + DSEQ);
                    sample_qkv_finalize((const float*)(ws + WS_PART), b, 3072 + h * 128, 4096 + h * 128, 5120 + h * 128, 1.0f, BIG, out + OFF_BKS, out + OFF_BVS, 1024, h * 128, tid);
                    { if (EN(10)) { att::attn_item<true, 128, 1>(lds, a, wave0); } } idx = q_post(nx_, MISC + 12 + (idx & 1), tid); }
                while (idx < 128 + 1024) { Q_PRE(); const int p = idx - 128, j = 15 - (p >> 6), s = p & 63, b = s >> 3, h = s & 7;
                    const bf16_t* base = BIG + (size_t)(b * SEQ) * NQKV + h * 128;
                    a.K1 = base + 1024; a.V1 = base + 2048; a.K2 = a.K1; a.V2 = a.V1; a.ks = NQKV;
                    a.Q = base + (size_t)(256 * j) * NQKV; a.qs = NQKV; a.O = ATT + (size_t)(b * SEQ + 256 * j) * DM + h * 128; a.os = DM;
                    a.nrows = 256; a.qpos0 = 256 * j; a.kpos0 = 0; a.nt = 4 * (j + 1); a.tsplit = 1 << 20; a.tabsrc = inp(lds, 24) + h; a.tabkind = 0;
                    { if (EN(11)) { att::attn_item<false, 64, 0>(lds, a, wave0); } } idx = q_post(nx_, MISC + 12 + (idx & 1), tid); }
                if (idx < 128 + 2048) {
                    if (tid == 0) { unsigned sp = 0; while (__hip_atomic_load(ctl + CW_KDONE, __ATOMIC_RELAXED, __HIP_MEMORY_SCOPE_AGENT) < (unsigned)G) { __builtin_amdgcn_s_sleep(2); if (++sp > (1u << 22)) break; } }
                    __syncthreads();
                }
                while (idx < 128 + 2048) { Q_PRE(); const int p = idx - 128 - 1024, j = 15 - (p >> 6), s = p & 63, b = s >> 3, h = s & 7;
                    const bf16_t* base = BIG + (size_t)(b * SEQ) * NQKV + h * 128;
                    a.K1 = base + 4096; a.V1 = base + 5120; a.K2 = a.K1; a.V2 = a.V1; a.ks = NQKV;
                    a.Q = base + 3072 + (size_t)(256 * j) * NQKV; a.qs = NQKV; a.O = ATT + (size_t)(b * SEQ + 256 * j) * DM + 1024 + h * 128; a.os = DM;
                    a.nrows = 256; a.qpos0 = 256 * j; a.kpos0 = 0; a.nt = 4 * (j + 1); a.tsplit = 1 << 20; a.F = (const float*)(ws + WS_FP) + (size_t)s * SEQ;
                    a.kmax2 = __uint_as_float(__hip_atomic_load(ctl + CW_KMX + s, __ATOMIC_RELAXED, __HIP_MEMORY_SCOPE_AGENT));
                    { if (EN(12)) { att::attn_item<false, 128, 1, true>(lds, a, wave0); } } idx = q_post(nx_, MISC + 12 + (idx & 1), tid); }
            } else {
                unsigned* qw = ctl + CW_Q1;
                int idx = q_next(qw, MISC + 12, tid);
                a.band = 8; a.tabkind = 1;
                while (idx < 128) { Q_PRE(); const int b = idx >> 4, h = idx & 15;
                    a.K1 = inp(lds, 7) + ((size_t)b * 512 * 16 + h) * 128; a.V1 = inp(lds, 8) + ((size_t)b * 512 * 16 + h) * 128;
                    a.K2 = out + OFF_CKS + ((size_t)b * DSEQ * 16 + h) * 128; a.V2 = out + OFF_CVS + ((size_t)b * DSEQ * 16 + h) * 128; a.ks = 2048;
                    a.Q = BIG + (size_t)(MP + b * DSEQ) * NQKV + h * 128; a.qs = NQKV; a.O = ATT + (size_t)(MP + b * DSEQ) * DM + h * 128; a.os = DM;
                    a.nrows = 64; a.qpos0 = PAST; a.kpos0 = PAST - 512; a.nt = 9; a.tsplit = 8; a.tabsrc = inp(lds, 27) + h;
                    sample_qkv_finalize((const float*)(ws + WS_PART), b, h * 128, 2048 + h * 128, 4096 + h * 128, 1.0f, BIG, out + OFF_CKS, out + OFF_CVS, 2048, h * 128, tid);
                    { if (EN(13)) { att::attn_item<true, 128, 0>(lds, a, wave0); } } idx = q_post(nx_, MISC + 12 + (idx & 1), tid); }
                while (idx < 128 + 2048) { Q_PRE(); const int p = idx - 128, j = 15 - (p >> 7), s = p & 127, b = s >> 4, h = s & 15;
                    const int c0 = (4 * j - 8) > 0 ? (4 * j - 8) : 0;
                    const bf16_t* base = BIG + (size_t)(b * SEQ) * NQKV + h * 128;
                    a.K1 = base + 2048 + (size_t)(64 * c0) * NQKV; a.V1 = base + 4096 + (size_t)(64 * c0) * NQKV; a.K2 = a.K1; a.V2 = a.V1; a.ks = NQKV;
                    a.Q = base + (size_t)(256 * j) * NQKV; a.qs = NQKV; a.O = ATT + (size_t)(b * SEQ + 256 * j) * DM + h * 128; a.os = DM;
                    a.nrows = 256; a.qpos0 = 256 * j; a.kpos0 = 64 * c0; a.nt = 4 * j + 4 - c0; a.tsplit = 1 << 20; a.tabsrc = inp(lds, 27) + h;
                    { if (EN(14)) { att::attn_item<false, 128, 0>(lds, a, wave0); } } idx = q_post(nx_, MISC + 12 + (idx & 1), tid); }
            }
        } PH_END
        PH_BEGIN { pg8::Gemm g{ATT, (const bf16_t*)(ws + (l == 0 ? WS_WOUTAB : WS_WOUTC)), MROWS, DM, DM}; pg8::SplitOrder S; S.init(DM, DM, 8, G, wg);
            EpiResGate E{nullptr, XB, MODS_L + 5 * DM, 1.0f, (float*)(ws + WS_PART)}; { if (EN(7)) { pg8::gemm_phase<EpiResGate, pg8::SplitOrder, true, true>(lds, g, S, E, wave0); } } } PH_END
        PH_BEGIN { if (EN(2)) { norm_phase<false>(nullptr, nullptr, XB, NG_L + 2 * DM, MODS_L, 6, H, nullptr, nullptr, out, SampleFix{(const float*)(ws + WS_PART), 8, MODS_L + 5 * DM, 1.0f}, lds, G, wg, tid, wave, lane); } } PH_END
        PH_BEGIN { pg8::Gemm g{H, (const bf16_t*)(ws + WS_WFI + (size_t)(l * 2 + 1) * SZ_WFI), MROWS, 11008, DM}; pg8::StaticOrder S; S.init(MROWS, 11008, G, wg); S.ntk = DM / 64;
            EpiSwiGLU E{BIG}; { if (EN(6)) { pg8::gemm_phase<EpiSwiGLU, pg8::StaticOrder, true, true>(lds, g, S, E, wave0); } } } PH_END
        PH_BEGIN { pg8::Gemm g{BIG, (const bf16_t*)(ws + WS_WFO + (size_t)(l * 2 + 1) * SZ_WFO), MROWS, DM, DFF}; pg8::SplitOrder S; S.init(DFF, DM, 15, G, wg);
            EpiResGate E{nullptr, XB, MODS_L + 8 * DM, 0.5f, (float*)(ws + WS_PART)}; { if (EN(7)) { pg8::gemm_phase<EpiResGate, pg8::SplitOrder, true, true>(lds, g, S, E, wave0); } } } PH_END
#undef PH_BEGIN
#undef PH_END
}

__global__ void __launch_bounds__(512, 2) mega_fwd(KArgs args) {
    extern __shared__ __attribute__((aligned(16))) unsigned char lds_raw[];
    LAS unsigned char* lds = (LAS unsigned char*)lds_raw;
    volatile LAS unsigned* MISC = (volatile LAS unsigned*)(lds + MISC_OFF);
    const int tid0 = threadIdx.x;
    const int wave0 = __builtin_amdgcn_readfirstlane(tid0 >> 6);
    const int G = gridDim.x, wg = blockIdx.x;
    unsigned char* ws = args.ws; float* out = args.out;
    unsigned* ctl = (unsigned*)(ws + WS_CTL);
    for (int u = tid0; u < (LDS_BYTES - LDSCTL_OFF) / 4; u += 512) ((LAS unsigned*)(lds + LDSCTL_OFF))[u] = 0u;
    __syncthreads();
    if (tid0 == 0) {
#pragma unroll
        for (int i = 0; i < 29; ++i) ((LAS unsigned long long*)(lds + PTAB_OFF))[i] = (unsigned long long)args.in.p[i];
    }
    __syncthreads();
    XcdBarrier bar; bar.bar = ctl + CW_BAR; bar.x = 0; bar.st = nullptr;
    if (MK_N_LAUNCHES == 1) bar = xcd_barrier_post(ctl + CW_BAR, MISC + 8, tid0);
    const int lo = args.ph_lo, hi_ = args.ph_hi;
    int phase = 0;
#define PH_BEGIN if (phase >= lo && phase < hi_) { const int tid = fresh_tid(wave0), lane = tid & 63, wave = __builtin_amdgcn_readfirstlane(tid >> 6); (void)lane; (void)wave;
#define PH_END   if (MK_N_LAUNCHES == 1) xcd_barrier(bar, fresh_tid(wave0)); } ++phase;

    bf16_t* H = (bf16_t*)(ws + WS_H); bf16_t* BIG = (bf16_t*)(ws + WS_BIG); bf16_t* ATT = (bf16_t*)(ws + WS_ATT);
    float* mods = (float*)(ws + WS_MODS);

    PH_BEGIN { if (EN(0)) { prologue_phase(ws, lds, G, wg, tid, wave, lane); } } PH_END
    PH_BEGIN { if (EN(1)) { mods_finalize(lds, ws, G, wg, tid); } } PH_END

    layer_phases<0>(lds, ws, out, ctl, bar, G, wg, wave0, lo, hi_, phase);
    layer_phases<1>(lds, ws, out, ctl, bar, G, wg, wave0, lo, hi_, phase);
    PH_BEGIN { if (EN(4)) { final_norm_phase((bf16_t*)(ws + WS_XB), out, inp(lds, 28), SampleFix{(const float*)(ws + WS_PART), 15, (const float*)(ws + WS_MODS) + (size_t)16 * NADA + 8 * DM, 0.5f}, G, wg, wave, lane); } } }
#undef PH_BEGIN
#undef PH_END
}
constexpr int N_PHASES = 64;

extern "C" void kernel_launch(void* const* d_in, const int* in_sizes, int n_in, void* d_out, int out_size, void* d_ws, size_t ws_size, hipStream_t stream) {
    static int grid = 0;
    if (grid == 0) {
        if (n_in != 29 || (size_t)out_size != OUT_TOTAL || ws_size < WS_END) { fprintf(stderr, "kernel_launch: unexpected shapes (n_in %d, out %d, ws %zu; need ws >= %zu)\n", n_in, out_size, ws_size, (size_t)WS_END); grid = -1; return; }
        int dev = 0, cus = 0;
        if (hipGetDevice(&dev) != hipSuccess || hipDeviceGetAttribute(&cus, hipDeviceAttributeMultiprocessorCount, dev) != hipSuccess) { grid = -1; return; }
        if (hipFuncSetAttribute((const void*)mega_fwd, hipFuncAttributeMaxDynamicSharedMemorySize, LDS_BYTES) != hipSuccess) { fprintf(stderr, "kernel_launch: hipFuncSetAttribute failed\n"); grid = -1; return; }
        int per_cu = 0;
        if (hipOccupancyMaxActiveBlocksPerMultiprocessor(&per_cu, (const void*)mega_fwd, 512, LDS_BYTES) != hipSuccess || per_cu < 1) { fprintf(stderr, "kernel_launch: occupancy query says %d blocks per CU\n", per_cu); }
        (void)hipGetLastError();
        grid = cus;
    }
    if (grid < 0) return;
    (void)hipMemsetAsync((char*)d_ws + WS_CTL, 0, 128 * 1024, stream);
    KArgs a{};
    for (int i = 0; i < 29; ++i) a.in.p[i] = (const float*)d_in[i];
    a.out = (float*)d_out; a.ws = (unsigned char*)d_ws;
    if (MK_N_LAUNCHES == 1) { a.ph_lo = 0; a.ph_hi = N_PHASES; hipLaunchKernelGGL(mega_fwd, dim3(grid), dim3(512), LDS_BYTES, stream, a); }
    else { for (int p = 0; p < N_PHASES; ++p) { a.ph_lo = p; a.ph_hi = p + 1; hipLaunchKernelGGL(mega_fwd, dim3(grid), dim3(512), LDS_BYTES, stream, a); } }
}
```

```cpp
#include <hip/hip_runtime.h>
#include <cstdio>
#include <cstdint>

#ifndef MK_N_LAUNCHES
#define MK_N_LAUNCHES 1
#endif

#ifndef DIS
#define DIS 0
#endif
#define EN(bit) (!(((DIS) >> (bit)) & 1))
#define LAS __attribute__((address_space(3)))
typedef unsigned short bf16_t;
typedef short bf16x8 __attribute__((ext_vector_type(8)));
typedef short s16x4 __attribute__((ext_vector_type(4)));
typedef float f32x4 __attribute__((ext_vector_type(4)));
typedef float f32x16 __attribute__((ext_vector_type(16)));
typedef unsigned u32x4 __attribute__((ext_vector_type(4)));
typedef unsigned u32x2 __attribute__((ext_vector_type(2)));

constexpr int DM = 2048, NBATCH = 8, SEQ = 4096, DSEQ = 64, PAST = 4096, DFF = 5504, NADA = 9 * DM;
constexpr int MP = NBATCH * SEQ, MS = NBATCH * DSEQ, MROWS = MP + MS;
constexpr int NQKV = 6144, LD_WINAB = 6152;
constexpr float LOG2E = 1.4426950408889634f;
constexpr float QSCALE_A = 0.125f * LOG2E;
constexpr float QSCALE_B = 0.08838834764831845f * LOG2E;
constexpr float EPS = 1e-6f;

constexpr size_t OFF_Y = 0;
constexpr size_t OFF_AKP = 68157440, OFF_AVP = 101711872, OFF_BKP = 135266304, OFF_BVP = 168820736, OFF_BFP = 202375168;
constexpr size_t OFF_CKP = 202637312, OFF_CVP = 211025920;
constexpr size_t OFF_AKS = 219414528, OFF_AVS = 219938816, OFF_BKS = 220463104, OFF_BVS = 220987392, OFF_BFS = 221511680;
constexpr size_t OFF_CKS = 221515776, OFF_CVS = 222564352, OUT_TOTAL = 223612928;

constexpr size_t MiB = 1u << 20;
constexpr size_t WS_CTL = 0, CTL_BYTES = 1 * MiB;
constexpr size_t SZ_WFI = (size_t)11008 * 2048 * 2, SZ_WFO = (size_t)2048 * 5504 * 2;
constexpr size_t WS_WFI = 1 * MiB;
constexpr size_t WS_WFO = WS_WFI + 4 * SZ_WFI;
constexpr size_t WS_WINAB = WS_WFO + 4 * SZ_WFO;
constexpr size_t WS_WOUTAB = WS_WINAB + 24 * MiB;
constexpr size_t WS_WINC = WS_WOUTAB + 8 * MiB;
constexpr size_t WS_WOUTC = WS_WINC + 24 * MiB;
constexpr size_t WS_H = WS_WOUTC + 8 * MiB;
constexpr size_t WS_BIG = WS_H + 130 * MiB;
constexpr size_t WS_ATT = WS_BIG + 390 * MiB;
constexpr size_t WS_MODP = WS_ATT + 130 * MiB;
constexpr size_t WS_MODS = WS_MODP + 18 * MiB;
constexpr size_t WS_FP = WS_MODS + 3 * MiB;
constexpr size_t WS_FS = WS_FP + 1 * MiB;
constexpr size_t WS_O1 = WS_FS + 2 * MiB;
constexpr size_t WS_PART = WS_O1 + 32 * MiB;
constexpr size_t WS_XB = WS_PART + 60 * MiB;
constexpr size_t WS_END = WS_XB + 130 * MiB;

constexpr int CW_BAR = 4096;
constexpr int CW_Q0 = 16384, CW_Q1 = 16384 + 64;
constexpr int CW_KMX = 16384 + 256, CW_KDONE = 16384 + 512;

constexpr int RING_BYTES = 131072;
constexpr int LDSCTL_OFF = RING_BYTES, MISC_OFF = LDSCTL_OFF + 320, PTAB_OFF = LDSCTL_OFF + 1024;
constexpr int LDS_BYTES = 147456;

#define LDS_WAIT() asm volatile("s_waitcnt lgkmcnt(0)" ::: "memory")
#define VM_WAIT() asm volatile("s_waitcnt vmcnt(0)" ::: "memory")
#define SBAR() __builtin_amdgcn_sched_barrier(0)

__device__ __forceinline__ int fresh_tid(int wave_s) { asm volatile("" : "+s"(wave_s)); int l;
    asm volatile("v_mbcnt_lo_u32_b32 %0, -1, 0\n\tv_mbcnt_hi_u32_b32 %0, -1, %0" : "=v"(l));
    return wave_s * 64 + l; }
__device__ __forceinline__ int fresh_s(int x) { asm volatile("" : "+s"(x)); return x; }
__device__ __forceinline__ unsigned cvtpk(float lo, float hi) { unsigned r; asm volatile("v_cvt_pk_bf16_f32 %0, %1, %2" : "=v"(r) : "v"(lo), "v"(hi)); return r; }
__device__ __forceinline__ bf16x8 pack8(f32x4 a, f32x4 b) {
    u32x4 w = {cvtpk(a[0], a[1]), cvtpk(a[2], a[3]), cvtpk(b[0], b[1]), cvtpk(b[2], b[3])};
    return *reinterpret_cast<bf16x8*>(&w);
}
__device__ __forceinline__ float wave_sum(float v) {
#pragma unroll
    for (int o = 1; o < 64; o <<= 1) v += __shfl_xor(v, o);
    return v;
}

namespace pg8 {
#define PG8_LAS __attribute__((address_space(3)))
constexpr int BM = 256, BK = 64, HALF = 128, HTB = HALF * BK * 2, STAGE_BYTES = 8 * HTB, NXCD = 8, WGM = 8;
__host__ __device__ __forceinline__ int lds_byte(int r, int c) { const int st = (r >> 4) * 2 + (c >> 5), rr = r & 15, cc = c & 31, ob = rr * 64 + cc * 2; return st * 1024 + (ob ^ (((ob >> 9) & 1) << 5)); }
__host__ __device__ __forceinline__ void stage_rc(int b, int& R, int& C) { const int st = b / 1024, sb = b % 1024, swz = sb ^ (((sb >> 9) & 1) << 5); R = (st >> 1) * 16 + swz / 64; C = (st & 1) * 32 + (swz % 64) / 2; }
__host__ __device__ __forceinline__ int perm32(int rho) { const int n = rho >> 4, i = rho & 15; return 8 * (i >> 2) + 4 * n + (i & 3); }
struct Unit { int pm, pn, kofs, nt, part; };
struct Gemm { const bf16_t* A; const bf16_t* Bt; int M, N, K; };
struct StaticOrder {
    int nM, nN, nwg, G, c, ntk, wgm;
    __host__ __device__ __forceinline__ void init(int M, int N, int G_, int c_) { nM = M / BM; nN = N / BM; nwg = nM * nN; G = G_; c = c_; ntk = 0; wgm = 4; }
    __host__ __device__ __forceinline__ bool next(int i, Unit& u) const {
        const long L = (long)i * G + c; if (L >= nwg) return false;
        int wgid = (int)L; { const int q = nwg / NXCD, r = nwg % NXCD, xcd = wgid % NXCD, off = wgid / NXCD; wgid = (xcd < r ? xcd * (q + 1) : r * (q + 1) + (xcd - r) * q) + off; }
        const int nig = wgm * nN, gid = wgid / nig, fm = gid * wgm, gsz = (nM - fm) < wgm ? (nM - fm) : wgm;
        u.pm = fm + ((wgid % nig) % gsz); u.pn = (wgid % nig) / gsz; u.kofs = 0; u.nt = ntk; u.part = -1; return true;
    }
    __device__ __forceinline__ void a_ready(const Unit&) const {}
    __device__ __forceinline__ void done(const Unit&) const {}
};
struct SplitOrder {
    StaticOrder so; int S, nitems, base, rem, G, c, npre, nmine;
    __device__ __forceinline__ void init(int Kfull, int N, int S_, int G_, int c_) { so.init(MP, N, G_, c_); so.ntk = Kfull / BK; if (N / BM == 8) so.wgm = 4; S = S_; nitems = 2 * (N / BM) * S; const int chunks = Kfull / 128; base = chunks / S; rem = chunks % S; G = G_; c = c_;
        npre = ((c & 1) && c < nitems) ? 1 : 0; nmine = (so.nwg > c) ? (so.nwg - 1 - c) / G + 1 : 0; }
    __device__ __forceinline__ bool next(int i, Unit& u) const {
        const int j = i - npre;
        if (j >= 0 && j < nmine) return so.next(j, u);
        if (c >= nitems || !((npre && i == 0) || (!npre && j == nmine))) return false;
        const int unit = c / S, s = c % S, start = s * base + (s < rem ? s : rem), len = base + (s < rem ? 1 : 0);
        u.pm = MP / BM + unit / (so.nN); u.pn = unit % so.nN; u.kofs = start * 128; u.nt = len * 2; u.part = s; return true;
    }
    __device__ __forceinline__ void a_ready(const Unit&) const {}
    __device__ __forceinline__ void done(const Unit&) const {}
};
template <class Epi, class Sched, bool ALIGN_EPI = false, bool SP2 = false>
__device__ __forceinline__ void gemm_phase(PG8_LAS unsigned char* lds, const Gemm g, const Sched& S, const Epi& E, int wave_s) {
    const int tid = fresh_tid(wave_s), wid = __builtin_amdgcn_readfirstlane(tid >> 6), lane = tid & 63, wr = wid >> 2, wc = wid & 3, fr = lane & 15, fq = lane >> 4;
    const int K = g.K;
    unsigned voffA[2], voffB[2];
#pragma unroll
    for (int i = 0; i < 2; ++i) { int R, C; stage_rc(tid * 16 + i * 8192, R, C); const int Rb = Epi::PERM ? ((R & ~31) + perm32(R & 31)) : R;
        voffA[i] = (unsigned)(R * K + C) * 2u; voffB[i] = (unsigned)(Rb * K + C) * 2u; }
    const size_t kstep = (size_t)(BK * 2);
    const size_t hstep = (size_t)HALF * K * 2;
    const size_t tstep = 2 * hstep;
    const unsigned ldsw = (unsigned)wid * 1024u;
    const int aoff = lds_byte(wr * 64 + fr, fq * 8), boff = lds_byte(wc * 32 + fr, fq * 8);
#define PG8_SA(b, h) (((b) * 2 + (h)) * HTB)
#define PG8_SB(b, h) ((4 + (b) * 2 + (h)) * HTB)
#define PG8_STAGE(bufoff, gbase, voff) do { _Pragma("unroll") for (int _i = 0; _i < 2; ++_i) \
        __builtin_amdgcn_global_load_lds((const unsigned*)((const char*)(gbase) + (voff)[_i]), (PG8_LAS unsigned*)(lds + (bufoff) + ldsw + _i * 8192), 16, 0, 0); } while (0)
#define PG8_LDA(dst, b, h) do { _Pragma("unroll") for (int m = 0; m < 4; ++m) _Pragma("unroll") for (int k = 0; k < 2; ++k) dst[m][k] = *(const PG8_LAS bf16x8*)(lds + PG8_SA(b, h) + aoff + m * 2048 + k * 1024); } while (0)
#define PG8_LDB(dst, b, h) do { _Pragma("unroll") for (int n = 0; n < 2; ++n) _Pragma("unroll") for (int k = 0; k < 2; ++k) dst[n][k] = *(const PG8_LAS bf16x8*)(lds + PG8_SB(b, h) + boff + n * 2048 + k * 1024); } while (0)
#define PG8_MMA(ai, bj, At, Bt) do { __builtin_amdgcn_s_setprio(1); _Pragma("unroll") for (int m = 0; m < 4; ++m) _Pragma("unroll") for (int n = 0; n < 2; ++n) _Pragma("unroll") for (int k = 0; k < 2; ++k) \
        acc[ai][bj][m][n] = __builtin_amdgcn_mfma_f32_16x16x32_bf16(Bt[n][k], At[m][k], acc[ai][bj][m][n], 0, 0, 0); __builtin_amdgcn_s_setprio(0); } while (0)
#define PG8_WAIT_V(n) asm volatile("s_waitcnt vmcnt(" #n ")" ::: "memory")
#define PG8_WAIT_L(n) asm volatile("s_waitcnt lgkmcnt(" #n ")" ::: "memory")
#define PG8_BAR __builtin_amdgcn_s_barrier()
#define PG8_SCHED __builtin_amdgcn_sched_barrier(0)
    Unit cur, nxt; int ui = 0;
    if (!S.next(0, cur)) return;
    f32x4 acc[2][2][4][2];
#pragma unroll
    for (int a = 0; a < 2; ++a)
#pragma unroll
        for (int b = 0; b < 2; ++b)
#pragma unroll
            for (int m = 0; m < 4; ++m)
#pragma unroll
                for (int n = 0; n < 2; ++n) acc[a][b][m][n] = (f32x4){0.f, 0.f, 0.f, 0.f};
    bf16x8 At[4][2], B0[2][2], B1[2][2];
    int nt = cur.nt;
    const char* cA = (const char*)g.A + (size_t)cur.pm * tstep + (size_t)cur.kofs * 2; const char* cB = (const char*)g.Bt + (size_t)cur.pn * tstep + (size_t)cur.kofs * 2;
    S.a_ready(cur);
    if constexpr (SP2) {
        PG8_STAGE(PG8_SB(0, 0), cB, voffB); PG8_STAGE(PG8_SB(0, 1), cB + hstep, voffB); PG8_STAGE(PG8_SA(0, 0), cA, voffA); PG8_STAGE(PG8_SA(0, 1), cA + hstep, voffA);
        if (wr == 1) PG8_BAR;
        PG8_WAIT_V(2); PG8_BAR;
        PG8_STAGE(PG8_SB(1, 0), cB + kstep, voffB); PG8_STAGE(PG8_SA(1, 0), cA + kstep, voffA); PG8_STAGE(PG8_SB(1, 1), cB + hstep + kstep, voffB);
        PG8_WAIT_V(6); PG8_BAR;
    } else {
        PG8_STAGE(PG8_SB(0, 0), cB, voffB); PG8_STAGE(PG8_SA(0, 0), cA, voffA); PG8_STAGE(PG8_SB(0, 1), cB + hstep, voffB); PG8_STAGE(PG8_SA(0, 1), cA + hstep, voffA);
        if (wr == 1) PG8_BAR;
        PG8_WAIT_V(4); PG8_BAR;
        PG8_STAGE(PG8_SB(1, 0), cB + kstep, voffB); PG8_STAGE(PG8_SA(1, 0), cA + kstep, voffA); PG8_STAGE(PG8_SB(1, 1), cB + hstep + kstep, voffB);
        PG8_WAIT_V(6); PG8_BAR;
    }
    for (;;) {
        const bool has_next = S.next(ui + 1, nxt);
        const char* nA = has_next ? (const char*)g.A + (size_t)nxt.pm * tstep + (size_t)nxt.kofs * 2 : cA; const char* nB = has_next ? (const char*)g.Bt + (size_t)nxt.pn * tstep + (size_t)nxt.kofs * 2 : cB;
        for (int t = 0; t < nt; t += 2) {
            const bool last = (t == nt - 2);
            const char* a1 = cA + (size_t)(t + 1) * kstep;
            const char* a2 = last ? nA : cA + (size_t)(t + 2) * kstep; const char* b2 = last ? nB : cB + (size_t)(t + 2) * kstep;
            const char* a3 = a2 + kstep; const char* b3 = b2 + kstep;
            if (last && has_next) S.a_ready(nxt);
            if constexpr (SP2) {
            PG8_LDB(B0, 0, 0); PG8_LDB(B1, 0, 1); PG8_SCHED; PG8_LDA(At, 0, 0); PG8_STAGE(PG8_SA(1, 1), a1 + hstep, voffA);
            PG8_WAIT_V(8); PG8_WAIT_L(0); PG8_BAR; PG8_MMA(0, 0, At, B0); PG8_MMA(0, 1, At, B1); PG8_BAR; PG8_SCHED;
            PG8_LDA(At, 0, 1); PG8_STAGE(PG8_SB(0, 0), b2, voffB); PG8_STAGE(PG8_SB(0, 1), b2 + hstep, voffB); PG8_STAGE(PG8_SA(0, 0), a2, voffA);
            PG8_WAIT_V(8); PG8_WAIT_L(0); PG8_BAR; PG8_MMA(1, 0, At, B0); PG8_MMA(1, 1, At, B1); PG8_BAR; PG8_SCHED;
            PG8_LDB(B0, 1, 0); PG8_LDB(B1, 1, 1); PG8_SCHED; PG8_LDA(At, 1, 0); PG8_STAGE(PG8_SA(0, 1), a2 + hstep, voffA);
            PG8_WAIT_V(8); PG8_WAIT_L(0); PG8_BAR; PG8_MMA(0, 0, At, B0); PG8_MMA(0, 1, At, B1); PG8_BAR; PG8_SCHED;
            PG8_LDA(At, 1, 1); PG8_STAGE(PG8_SB(1, 0), b3, voffB); PG8_STAGE(PG8_SB(1, 1), b3 + hstep, voffB); PG8_STAGE(PG8_SA(1, 0), a3, voffA);
            PG8_WAIT_V(8); PG8_WAIT_L(0); PG8_BAR; PG8_MMA(1, 0, At, B0); PG8_MMA(1, 1, At, B1); PG8_BAR; PG8_SCHED;
            } else {
            PG8_LDB(B0, 0, 0); PG8_SCHED; PG8_LDA(At, 0, 0); PG8_STAGE(PG8_SA(1, 1), a1 + hstep, voffA);
            PG8_WAIT_L(8); PG8_BAR; PG8_WAIT_L(0); PG8_MMA(0, 0, At, B0); PG8_BAR; PG8_SCHED;
            PG8_LDB(B1, 0, 1); PG8_STAGE(PG8_SB(0, 0), b2, voffB);
            PG8_BAR; PG8_WAIT_L(0); PG8_MMA(0, 1, At, B1); PG8_BAR;
            PG8_LDA(At, 0, 1); PG8_STAGE(PG8_SA(0, 0), a2, voffA);
            PG8_BAR; PG8_WAIT_L(0); PG8_MMA(1, 0, At, B0); PG8_BAR; PG8_SCHED;
            PG8_STAGE(PG8_SB(0, 1), b2 + hstep, voffB);
            PG8_WAIT_V(6); PG8_BAR; PG8_MMA(1, 1, At, B1); PG8_BAR;
            PG8_LDB(B0, 1, 0); PG8_SCHED; PG8_LDA(At, 1, 0); PG8_STAGE(PG8_SA(0, 1), a2 + hstep, voffA);
            PG8_WAIT_L(8); PG8_BAR; PG8_WAIT_L(0); PG8_MMA(0, 0, At, B0); PG8_BAR; PG8_SCHED;
            PG8_LDB(B1, 1, 1); PG8_STAGE(PG8_SB(1, 0), b3, voffB);
            PG8_BAR; PG8_WAIT_L(0); PG8_MMA(0, 1, At, B1); PG8_BAR;
            PG8_LDA(At, 1, 1); PG8_STAGE(PG8_SA(1, 0), a3, voffA);
            PG8_BAR; PG8_WAIT_L(0); PG8_MMA(1, 0, At, B0); PG8_BAR; PG8_SCHED;
            PG8_STAGE(PG8_SB(1, 1), b3 + hstep, voffB);
            PG8_WAIT_V(6); PG8_BAR; PG8_MMA(1, 1, At, B1); PG8_BAR;
            }
        }
        if constexpr (ALIGN_EPI) { if (wr == 0) PG8_BAR; }
        E(acc, cur, wr, wc, fr, fq);
        if (!has_next) break;
#pragma unroll
        for (int a = 0; a < 2; ++a)
#pragma unroll
            for (int b = 0; b < 2; ++b)
#pragma unroll
                for (int m = 0; m < 4; ++m)
#pragma unroll
                    for (int n = 0; n < 2; ++n) acc[a][b][m][n] = (f32x4){0.f, 0.f, 0.f, 0.f};
        cur = nxt; cA = nA; cB = nB; ++ui; nt = cur.nt;
        if constexpr (ALIGN_EPI) { if (wr == 1) PG8_BAR; }
    }
    PG8_WAIT_V(0);
    if constexpr (!ALIGN_EPI) { if (wr == 0) PG8_BAR; }
    PG8_BAR;
#undef PG8_SA
#undef PG8_SB
#undef PG8_STAGE
#undef PG8_LDA
#undef PG8_LDB
#undef PG8_MMA
#undef PG8_WAIT_V
#undef PG8_WAIT_L
#undef PG8_BAR
#undef PG8_SCHED
}
}

struct EpiSwiGLU {
    static constexpr bool PERM = true;
    bf16_t* O;
    __device__ __forceinline__ void operator()(const f32x4 (&acc)[2][2][4][2], const pg8::Unit& u, int wr, int wc, int fr, int fq) const {
        const int row0 = u.pm * 256 + wr * 64 + fr, col0 = u.pn * 128 + wc * 32 + 8 * fq;
#pragma unroll
        for (int ai = 0; ai < 2; ++ai)
#pragma unroll
            for (int m = 0; m < 4; ++m) {
                bf16_t* rowp = O + (size_t)(row0 + ai * 128 + m * 16) * DFF + col0;
                float v[8];
#pragma unroll
                for (int n = 0; n < 2; ++n)
#pragma unroll
                    for (int j = 0; j < 4; ++j) {
                        const float t = acc[ai][0][m][n][j], uu = acc[ai][1][m][n][j];
                        v[n * 4 + j] = (t * uu) * __builtin_amdgcn_rcpf(1.0f + __builtin_amdgcn_exp2f(t));
                    }
                u32x4 w; w.x = cvtpk(v[0], v[1]); w.y = cvtpk(v[2], v[3]); w.z = cvtpk(v[4], v[5]); w.w = cvtpk(v[6], v[7]);
                *(u32x4*)rowp = w;
            }
    }
};
struct EpiResGate {
    static constexpr bool PERM = true;
    const float* xin_p;
    bf16_t* xb;
    const float* gate;
    float coef;
    float* part;
    __device__ __forceinline__ void operator()(const f32x4 (&acc)[2][2][4][2], const pg8::Unit& u, int wr, int wc, int fr, int fq) const {
        const int row0 = u.pm * 256 + wr * 64 + fr, col0 = u.pn * 256 + wc * 32 + 8 * fq;
        if (u.part >= 0) {
            float* pp = part + ((size_t)u.part * MS + (row0 - MP)) * DM + col0;
#pragma unroll
            for (int ai = 0; ai < 2; ++ai)
#pragma unroll
                for (int m = 0; m < 4; ++m)
#pragma unroll
                    for (int bj = 0; bj < 2; ++bj)
#pragma unroll
                        for (int n = 0; n < 2; ++n) *(f32x4*)(pp + (size_t)(ai * 128 + m * 16) * DM + bj * 128 + n * 4) = acc[ai][bj][m][n];
            return;
        }
        const int modrow = u.pm >> 4;
        const float* gp = gate + (size_t)modrow * NADA + col0;
        f32x4 gv[2][2];
#pragma unroll
        for (int bj = 0; bj < 2; ++bj)
#pragma unroll
            for (int n = 0; n < 2; ++n) gv[bj][n] = *(const f32x4*)(gp + bj * 128 + n * 4) * coef;
#pragma unroll
        for (int ai = 0; ai < 2; ++ai)
#pragma unroll
            for (int m = 0; m < 4; ++m) {
                const size_t off = (size_t)(row0 + ai * 128 + m * 16) * DM + col0;
#pragma unroll
                for (int bj = 0; bj < 2; ++bj) {
                    f32x4 x0, x1;
                    if (xin_p) { x0 = *(const f32x4*)(xin_p + off + bj * 128); x1 = *(const f32x4*)(xin_p + off + bj * 128 + 4); }
                    else { const u32x4 w = *(const u32x4*)(xb + off + bj * 128);
                        x0 = (f32x4){__uint_as_float(w.x << 16), __uint_as_float(w.x & 0xffff0000u), __uint_as_float(w.y << 16), __uint_as_float(w.y & 0xffff0000u)};
                        x1 = (f32x4){__uint_as_float(w.z << 16), __uint_as_float(w.z & 0xffff0000u), __uint_as_float(w.w << 16), __uint_as_float(w.w & 0xffff0000u)}; }
                    x0 += gv[bj][0] * acc[ai][bj][m][0]; x1 += gv[bj][1] * acc[ai][bj][m][1];
                    u32x4 o; o.x = cvtpk(x0[0], x0[1]); o.y = cvtpk(x0[2], x0[3]); o.z = cvtpk(x1[0], x1[1]); o.w = cvtpk(x1[2], x1[3]);
                    *(u32x4*)(xb + off + bj * 128) = o;
                }
            }
    }
};
struct EpiQKV {
    static constexpr bool PERM = true;
    bf16_t* O;
    float* out;
    int layer1;
    float* part;
    __device__ __forceinline__ void operator()(const f32x4 (&acc)[2][2][4][2], const pg8::Unit& u, int wr, int wc, int fr, int fq) const {
        if (u.part >= 0) {
            float* pp = part + ((size_t)u.part * MS + (u.pm * 256 - MP + wr * 64 + fr)) * NQKV + u.pn * 256 + wc * 32 + 8 * fq;
#pragma unroll
            for (int ai = 0; ai < 2; ++ai)
#pragma unroll
                for (int m = 0; m < 4; ++m)
#pragma unroll
                    for (int bj = 0; bj < 2; ++bj)
#pragma unroll
                        for (int n = 0; n < 2; ++n) *(f32x4*)(pp + (size_t)(ai * 128 + m * 16) * NQKV + bj * 128 + n * 4) = acc[ai][bj][m][n];
            return;
        }
        const int sh = layer1 ? 3 : 2;
        const int sec = u.pn >> sh, colw = (u.pn & ((1 << sh) - 1)) * 256, ldf = 256 << sh;
        const int row0 = u.pm * 256 + wr * 64 + fr, cw = wc * 32 + 8 * fq;
        const bool samp = u.pm >= 128;
        size_t fo = 0;
        if (!layer1) { if (sec == 1) fo = samp ? OFF_AKS : OFF_AKP; else if (sec == 2) fo = samp ? OFF_AVS : OFF_AVP; else if (sec == 4) fo = samp ? OFF_BKS : OFF_BKP; else if (sec == 5) fo = samp ? OFF_BVS : OFF_BVP; }
        else { if (sec == 1) fo = samp ? OFF_CKS : OFF_CKP; else if (sec == 2) fo = samp ? OFF_CVS : OFF_CVP; }
        float* fdst = nullptr;
        if (fo) {
            if (samp) fdst = out + fo + (size_t)(u.pm * 256 - MP) * ldf;
            else if (!layer1) fdst = out + fo + (size_t)(u.pm * 256) * ldf;
            else if ((u.pm & 15) >= 14) { const int b = u.pm >> 4; fdst = out + fo + (size_t)(u.pm * 256 - (b + 1) * 3584) * ldf; }
        }
#pragma unroll
        for (int ai = 0; ai < 2; ++ai)
#pragma unroll
            for (int m = 0; m < 4; ++m) {
                const int rl = ai * 128 + m * 16;
                bf16_t* rowp = O + (size_t)(row0 + rl) * NQKV + u.pn * 256 + cw;
#pragma unroll
                for (int bj = 0; bj < 2; ++bj) {
                    const f32x4 v0 = acc[ai][bj][m][0], v1 = acc[ai][bj][m][1];
                    u32x4 w; w.x = cvtpk(v0[0], v0[1]); w.y = cvtpk(v0[2], v0[3]); w.z = cvtpk(v1[0], v1[1]); w.w = cvtpk(v1[2], v1[3]);
                    *(u32x4*)(rowp + bj * 128) = w;
                    if (fdst) { float* fr_ = fdst + (size_t)(wr * 64 + fr + rl) * ldf + colw + bj * 128 + cw;
                        __builtin_nontemporal_store(v0, (f32x4*)fr_); __builtin_nontemporal_store(v1, (f32x4*)(fr_ + 4)); }
                }
            }
    }
};

#define XB_TMO      128
#define XB_XCNT(j)  (256  + 64 * (j))
#define XB_XSUB(j)  (1280 + 64 * (j))
#define XB_XGEN(j)  (2304 + 64 * (j))
#define XB_TOP      3328
#define XB_TOPGEN   3392
#define XCD_BAR_WORDS 3456
#define XB_SPIN_CAP (1u << 18)
__device__ __forceinline__ unsigned xb_ld(unsigned* p)              { return __hip_atomic_load(p, __ATOMIC_RELAXED, __HIP_MEMORY_SCOPE_AGENT); }
__device__ __forceinline__ unsigned xb_add(unsigned* p, unsigned v) { return __hip_atomic_fetch_add(p, v, __ATOMIC_RELAXED, __HIP_MEMORY_SCOPE_AGENT); }
__device__ __forceinline__ unsigned xb_xcc_id() { return (unsigned)__builtin_amdgcn_s_getreg((3 << 11) | 20) & 0xFu; }
#define XB_SPIN(cond, bar) do { unsigned _sp = 0; while (cond) { __builtin_amdgcn_s_sleep(1); \
    if ((++_sp & 255u) == 0u) { if (xb_ld(&(bar)[XB_TMO])) break; if (_sp > XB_SPIN_CAP) { atomicAdd(&(bar)[XB_TMO], 1u); break; } } } } while (0)
struct XcdBarrier { unsigned* bar; unsigned x; volatile LAS unsigned* st; };
__device__ __forceinline__ XcdBarrier xcd_barrier_post(unsigned* bar, volatile LAS unsigned* st, int tid) {
    XcdBarrier b; b.bar = bar; b.x = xb_xcc_id(); b.st = st;
    if (tid == 0) (void)xb_add(&bar[XB_XCNT(b.x)], 1u);
    return b;
}
__device__ __forceinline__ void xcd_barrier_complete(unsigned* bar, unsigned x, unsigned& nloc, unsigned& nx) {
    const unsigned G = gridDim.x * gridDim.y * gridDim.z;
    unsigned sum, cnt, mine, sp = 0u;
    for (;;) {
        sum = 0u; cnt = 0u; mine = 0u;
#pragma unroll
        for (unsigned j = 0; j < 16; ++j) { const unsigned c = xb_ld(&bar[XB_XCNT(j)]); sum += c; cnt += (c > 0u) ? 1u : 0u; }
        mine = xb_ld(&bar[XB_XCNT(x)]);
        if (sum == G) break;
        __builtin_amdgcn_s_sleep(1);
        if ((++sp & 255u) == 0u) { if (xb_ld(&bar[XB_TMO])) break; if (sp > XB_SPIN_CAP) { atomicAdd(&bar[XB_TMO], 1u); break; } }
    }
    nloc = mine > 0u ? mine : 1u; nx = cnt > 0u ? cnt : 1u;
}
__device__ __forceinline__ void xcd_barrier(const XcdBarrier& b, int tid) {
    asm volatile("s_waitcnt vmcnt(0)" ::: "memory");
    __syncthreads();
    if (tid == 0) {
        unsigned* bar = b.bar; asm volatile("" : "+s"(bar));
        __builtin_amdgcn_s_waitcnt(0);
        unsigned nloc = b.st[0], nx = b.st[1];
        if (nloc == 0u) { xcd_barrier_complete(bar, b.x, nloc, nx); b.st[0] = nloc; b.st[1] = nx; }
        const unsigned old = xb_add(&bar[XB_XSUB(b.x)], 1u);
        const unsigned gen = old / nloc;
        if (old + 1u == (gen + 1u) * nloc) {
            __builtin_amdgcn_fence(__ATOMIC_RELEASE, "agent");
            asm volatile("s_waitcnt vmcnt(0)" ::: "memory");
            const unsigned og = xb_add(&bar[XB_TOP], 1u);
            const unsigned tg = og / nx;
            if (og + 1u == (tg + 1u) * nx) xb_add(&bar[XB_TOPGEN], 1u);
            else XB_SPIN(xb_ld(&bar[XB_TOPGEN]) == tg, bar);
            __builtin_amdgcn_fence(__ATOMIC_ACQUIRE, "agent");
            xb_add(&bar[XB_XGEN(b.x)], 1u);
            asm volatile("s_waitcnt vmcnt(0)" ::: "memory");
        } else {
            XB_SPIN(xb_ld(&bar[XB_XGEN(b.x)]) == gen, bar);
            __builtin_amdgcn_fence(__ATOMIC_ACQUIRE, "agent");
            asm volatile("s_waitcnt vmcnt(0)" ::: "memory");
        }
    }
    __syncthreads();
}

__device__ __forceinline__ void transpose_block(const float* W, int ldw, int K, bf16_t* WT, int k0, int n0, int swiglu, int lane) {
    const int a = lane & 15, g = lane >> 4;
    const float* src = W + (size_t)(k0 + 16 * g) * ldw + n0 + 4 * a;
    f32x4 v[16];
#pragma unroll
    for (int kk = 0; kk < 16; ++kk) v[kk] = *(const f32x4*)(src + (size_t)kk * ldw);
#pragma unroll
    for (int j = 0; j < 4; ++j) {
        const int n = n0 + 4 * a + j;
        int R = n;
        if (swiglu == 1) { R = (n < DFF) ? ((n >> 7) * 256 + (n & 127)) : (((n - DFF) >> 7) * 256 + 128 + ((n - DFF) & 127));
            const float sc = (n < DFF) ? -LOG2E : -1.0f / LOG2E;
#pragma unroll
            for (int kk = 0; kk < 16; ++kk) v[kk][j] *= sc; }
        if (swiglu >= 2) {
            const float sc = (swiglu == 2) ? ((n < 1024) ? QSCALE_A : ((n >= 3072 && n < 4096) ? QSCALE_B : 1.0f)) : ((n < 2048) ? QSCALE_B : 1.0f);
#pragma unroll
            for (int kk = 0; kk < 16; ++kk) v[kk][j] *= sc; }
        u32x4 w0, w1;
        w0.x = cvtpk(v[0][j], v[1][j]); w0.y = cvtpk(v[2][j], v[3][j]); w0.z = cvtpk(v[4][j], v[5][j]); w0.w = cvtpk(v[6][j], v[7][j]);
        w1.x = cvtpk(v[8][j], v[9][j]); w1.y = cvtpk(v[10][j], v[11][j]); w1.z = cvtpk(v[12][j], v[13][j]); w1.w = cvtpk(v[14][j], v[15][j]);
        bf16_t* dst = WT + (size_t)R * K + k0 + 16 * g;
        *(u32x4*)dst = w0; *(u32x4*)(dst + 8) = w1;
    }
}
struct InPtrs { const float* p[29]; };
__device__ __forceinline__ const float* inp(LAS unsigned char* lds, int i) {
    int off = PTAB_OFF + 8 * i; asm volatile("" : "+v"(off));
    const unsigned long long v = *(volatile LAS unsigned long long*)(lds + off);
    const unsigned lo = __builtin_amdgcn_readfirstlane((unsigned)v), hi = __builtin_amdgcn_readfirstlane((unsigned)(v >> 32));
    return (const float*)(((unsigned long long)hi << 32) | lo);
}

__device__ __forceinline__ void prologue_phase(unsigned char* ws, LAS unsigned char* lds, int G, int wg, int tid, int wave, int lane) {
    const float* w_ada = inp(lds, 11); const float* c_p = inp(lds, 9); const float* c_s = inp(lds, 10);
    float* modp = (float*)(ws + WS_MODP);
    LAS float* sct = (LAS float*)lds;
    LAS f32x4* red = (LAS f32x4*)(lds + 16384);
    for (int u = wg; u < 1152; u += G) {
        const int l = u / 576, r = u % 576, cb = r >> 3, k8 = r & 7, k0 = k8 * 256;
        __syncthreads();
        if (tid < 256) {
            const int k = k0 + tid;
#pragma unroll
            for (int rr = 0; rr < 16; ++rr) { const float c = (rr < 8) ? c_p[rr * DM + k] : c_s[(rr - 8) * DM + k];
                sct[tid * 16 + rr] = c / (1.0f + __expf(-c)); }
        }
        __syncthreads();
        f32x4 acc[16];
#pragma unroll
        for (int rr = 0; rr < 16; ++rr) acc[rr] = (f32x4){0.f, 0.f, 0.f, 0.f};
        const float* wp = w_ada + ((size_t)l * DM + k0 + wave * 32) * NADA + cb * 256 + 4 * lane;
#pragma unroll 4
        for (int kk = 0; kk < 32; ++kk) {
            const f32x4 wv = *(const f32x4*)(wp + (size_t)kk * NADA);
            const LAS f32x4* sp = (const LAS f32x4*)(sct + (wave * 32 + kk) * 16);
            const f32x4 s0 = sp[0], s1 = sp[1], s2 = sp[2], s3 = sp[3];
#pragma unroll
            for (int e = 0; e < 4; ++e) { acc[e] += wv * s0[e]; acc[4 + e] += wv * s1[e]; acc[8 + e] += wv * s2[e]; acc[12 + e] += wv * s3[e]; }
        }
#pragma unroll
        for (int p = 0; p < 2; ++p) {
#pragma unroll
            for (int i = 0; i < 8; ++i) red[(wave * 8 + i) * 64 + lane] = acc[p * 8 + i];
            __syncthreads();
            { const int i = tid >> 6, ln = tid & 63; f32x4 s = red[i * 64 + ln];
#pragma unroll
              for (int w = 1; w < 8; ++w) s += red[(w * 8 + i) * 64 + ln];
              *(f32x4*)(modp + ((size_t)((k8 * 2 + l) * 16 + p * 8 + i)) * NADA + cb * 256 + 4 * ln) = s; }
            __syncthreads();
        }
    }
    constexpr int NB_FI = 32 * 172, NB_FO = 86 * 32, NB_IN = 32 * 96, NB_OUT = 32 * 32;
    constexpr int TOT = 4 * NB_FI + 4 * NB_FO + 2 * NB_IN + 2 * NB_OUT;
    for (int gb = wg * 8 + wave; gb < TOT; gb += G * 8) {
        int g = gb; const float* W; int ldw, K, nb64, swi = 0; bf16_t* WT;
        if (g < 4 * NB_FI) { const int m = g / NB_FI; g -= m * NB_FI; W = inp(lds, 14) + (size_t)m * DM * 11008; ldw = 11008; K = DM; nb64 = 172; swi = 1; WT = (bf16_t*)(ws + WS_WFI + (size_t)m * SZ_WFI); }
        else { g -= 4 * NB_FI;
            if (g < 4 * NB_FO) { const int m = g / NB_FO; g -= m * NB_FO; W = inp(lds, 15) + (size_t)m * DFF * DM; ldw = DM; K = DFF; nb64 = 32; WT = (bf16_t*)(ws + WS_WFO + (size_t)m * SZ_WFO); }
            else { g -= 4 * NB_FO;
                if (g < NB_IN) { W = inp(lds, 16); ldw = LD_WINAB; K = DM; nb64 = 96; swi = 2; WT = (bf16_t*)(ws + WS_WINAB); }
                else { g -= NB_IN;
                    if (g < NB_OUT) { W = inp(lds, 18); ldw = DM; K = DM; nb64 = 32; WT = (bf16_t*)(ws + WS_WOUTAB); }
                    else { g -= NB_OUT;
                        if (g < NB_IN) { W = inp(lds, 25); ldw = NQKV; K = DM; nb64 = 96; swi = 3; WT = (bf16_t*)(ws + WS_WINC); }
                        else { g -= NB_IN; W = inp(lds, 26); ldw = DM; K = DM; nb64 = 32; WT = (bf16_t*)(ws + WS_WOUTC); } } } } }
        const int kb = g / nb64, nb = g % nb64;
        transpose_block(W, ldw, K, WT, kb * 64, nb * 64, swi, lane);
    }
}
__device__ __forceinline__ void mods_finalize(LAS unsigned char* lds, unsigned char* ws, int G, int wg, int tid) {
    const float* modp = (const float*)(ws + WS_MODP); float* mods = (float*)(ws + WS_MODS); const float* b_ada = inp(lds, 12);
    constexpr int NV = 2 * 16 * NADA / 4;
    for (int i = wg * 512 + tid; i < NV; i += G * 512) {
        const int e = i * 4, l = e / (16 * NADA), rem = e % (16 * NADA), r = rem / NADA, j = rem % NADA;
        f32x4 s = *(const f32x4*)(b_ada + (size_t)l * NADA + j);
#pragma unroll
        for (int k8 = 0; k8 < 8; ++k8) s += *(const f32x4*)(modp + ((size_t)((k8 * 2 + l) * 16 + r)) * NADA + j);
        *(f32x4*)(mods + e) = s;
    }
}

__device__ __forceinline__ void load_row(f32x4 (&v)[8], const float* x32, const bf16_t* xb, int lane) {
    if (x32) {
#pragma unroll
        for (int j = 0; j < 8; ++j) v[j] = *(const f32x4*)(x32 + 4 * lane + 256 * j);
    } else {
#pragma unroll
        for (int j = 0; j < 8; ++j) { const u32x2 w = *(const u32x2*)(xb + 4 * lane + 256 * j);
            v[j] = (f32x4){__uint_as_float(w.x << 16), __uint_as_float(w.x & 0xffff0000u), __uint_as_float(w.y << 16), __uint_as_float(w.y & 0xffff0000u)}; }
    }
}
struct SampleFix { const float* part; int S; const float* gate; float coef; };
__device__ __forceinline__ void sample_fix(f32x4 (&v)[8], const SampleFix& fx, int srow, bf16_t* xb_row, int lane) {
    f32x4 acc[8];
#pragma unroll
    for (int j = 0; j < 8; ++j) acc[j] = (f32x4){0.f, 0.f, 0.f, 0.f};
#pragma unroll 1
    for (int sl = 0; sl < fx.S; ++sl) { const float* pp = fx.part + ((size_t)sl * MS + srow) * DM + 4 * lane;
#pragma unroll
        for (int j = 0; j < 8; ++j) acc[j] += *(const f32x4*)(pp + 256 * j); }
    const float* gp = fx.gate + (size_t)(8 + (srow >> 6)) * NADA + 4 * lane;
#pragma unroll
    for (int j = 0; j < 8; ++j) { v[j] += *(const f32x4*)(gp + 256 * j) * fx.coef * acc[j];
        u32x2 w; w.x = cvtpk(v[j][0], v[j][1]); w.y = cvtpk(v[j][2], v[j][3]);
        *(u32x2*)(xb_row + 4 * lane + 256 * j) = w;
        v[j] = (f32x4){__uint_as_float(w.x << 16), __uint_as_float(w.x & 0xffff0000u), __uint_as_float(w.y << 16), __uint_as_float(w.y & 0xffff0000u)}; }
}
template <bool FGATE>
__device__ __forceinline__ void norm_row(f32x4 (&v)[8], bf16_t* hrow, const f32x4 (&gs)[8], const f32x4 (&sh)[8], int lane,
                                         const LAS f32x4* wfA, const LAS f32x4* wfB, const float* bf, float* fout) {
    float ss = 0.f;
#pragma unroll
    for (int j = 0; j < 8; ++j) ss += (v[j][0] * v[j][0] + v[j][1] * v[j][1]) + (v[j][2] * v[j][2] + v[j][3] * v[j][3]);
    const float rstd = 1.0f / sqrtf(wave_sum(ss) * (1.0f / DM) + EPS);
#pragma unroll
    for (int j = 0; j < 8; ++j) { v[j] = v[j] * rstd * gs[j] + sh[j];
        u32x2 w; w.x = cvtpk(v[j][0], v[j][1]); w.y = cvtpk(v[j][2], v[j][3]);
        *(u32x2*)(hrow + 4 * lane + 256 * j) = w; }
    if constexpr (FGATE) {
        f32x4 fa = {0.f, 0.f, 0.f, 0.f}, fb = {0.f, 0.f, 0.f, 0.f};
#pragma unroll
        for (int j = 0; j < 8; ++j)
#pragma unroll
            for (int e = 0; e < 4; ++e) { const f32x4 a = wfA[(j * 4 + e) * 64 + lane], b = wfB[(j * 4 + e) * 64 + lane]; fa += a * v[j][e]; fb += b * v[j][e]; }
        float z[8];
#pragma unroll
        for (int e = 0; e < 4; ++e) { z[e] = wave_sum(fa[e]); z[4 + e] = wave_sum(fb[e]); }
        float zz = z[0];
#pragma unroll
        for (int e = 1; e < 8; ++e) zz = (lane == e) ? z[e] : zz;
        if (lane < 8) { zz += bf[lane]; const float lf = fminf(zz, 0.f) - log1pf(expf(-fabsf(zz))); fout[lane] = lf; }
    }
}
template <bool FGATE>
__device__ __forceinline__ void norm_phase(const float* xp32, const float* xs32, bf16_t* xb, const float* g, const float* mods_l, int chunk, bf16_t* H,
                                           const float* wf_src, const float* bf, float* out, const SampleFix fx, LAS unsigned char* lds, int G, int wg, int tid, int wave, int lane) {
    const LAS f32x4* wfA = (const LAS f32x4*)lds; const LAS f32x4* wfB = (const LAS f32x4*)(lds + 32768);
    if constexpr (FGATE) {
        for (int c = tid; c < DM; c += 512) { const int j = c >> 8, ln = (c & 255) >> 2, e = c & 3, idx = (j * 4 + e) * 64 + ln;
            const float* s = wf_src + (size_t)c * LD_WINAB + 6144;
            ((LAS f32x4*)lds)[idx] = *(const f32x4*)s; ((LAS f32x4*)(lds + 32768))[idx] = *(const f32x4*)(s + 4); }
        __syncthreads();
    }
    f32x4 gs[8], sh[8], v[8], v2[8];
    for (int blk = wg; blk < 256; blk += G) {
        const int b = blk >> 5, r0 = b * SEQ + (blk & 31) * 128 + wave * 16;
        const float* shp = mods_l + (size_t)b * NADA + chunk * DM; const float* scp = shp + DM;
#pragma unroll
        for (int j = 0; j < 8; ++j) { const int c = 4 * lane + 256 * j; gs[j] = *(const f32x4*)(g + c) * (*(const f32x4*)(scp + c) + 1.0f); sh[j] = *(const f32x4*)(shp + c); }
        for (int i = 0; i < 16; i += 2) { const int row = r0 + i;
            load_row(v, xp32 ? xp32 + (size_t)row * DM : nullptr, xb + (size_t)row * DM, lane);
            load_row(v2, xp32 ? xp32 + (size_t)(row + 1) * DM : nullptr, xb + (size_t)(row + 1) * DM, lane);
            norm_row<FGATE>(v, H + (size_t)row * DM, gs, sh, lane, wfA, wfB, bf, FGATE ? out + OFF_BFP + (size_t)row * 8 : nullptr);
            norm_row<FGATE>(v2, H + (size_t)(row + 1) * DM, gs, sh, lane, wfA, wfB, bf, FGATE ? out + OFF_BFP + (size_t)(row + 1) * 8 : nullptr); }
    }
    for (int s = wave * G + wg; s < MS; s += 8 * G) {
        const int mr = 8 + (s >> 6);
        const float* shp = mods_l + (size_t)mr * NADA + chunk * DM; const float* scp = shp + DM;
#pragma unroll
        for (int j = 0; j < 8; ++j) { const int c = 4 * lane + 256 * j; gs[j] = *(const f32x4*)(g + c) * (*(const f32x4*)(scp + c) + 1.0f); sh[j] = *(const f32x4*)(shp + c); }
        load_row(v, xs32 ? xs32 + (size_t)s * DM : nullptr, xb + (size_t)(MP + s) * DM, lane);
        if (fx.S) sample_fix(v, fx, s, xb + (size_t)(MP + s) * DM, lane);
        norm_row<FGATE>(v, H + (size_t)(MP + s) * DM, gs, sh, lane, wfA, wfB, bf, FGATE ? out + OFF_BFS + (size_t)s * 8 : nullptr);
    }
}
__device__ __forceinline__ void final_norm_phase(bf16_t* xb, float* y, const float* g, const SampleFix fx, int G, int wg, int wave, int lane) {
    f32x4 gv[8], v[8], v2[8];
#pragma unroll
    for (int j = 0; j < 8; ++j) gv[j] = *(const f32x4*)(g + 4 * lane + 256 * j);
#define FN_ROW(V, ROW) do { float ss = 0.f; _Pragma("unroll") for (int j = 0; j < 8; ++j) ss += (V[j][0] * V[j][0] + V[j][1] * V[j][1]) + (V[j][2] * V[j][2] + V[j][3] * V[j][3]); \
        const float rstd = 1.0f / sqrtf(wave_sum(ss) * (1.0f / DM) + EPS); float* yr = y + (size_t)(ROW) * DM; \
        _Pragma("unroll") for (int j = 0; j < 8; ++j) __builtin_nontemporal_store(V[j] * rstd * gv[j], (f32x4*)(yr + 4 * lane + 256 * j)); } while (0)
    for (int row = (wg * 8 + wave) * 2; row < MP; row += G * 16) {
        load_row(v, nullptr, xb + (size_t)row * DM, lane); load_row(v2, nullptr, xb + (size_t)(row + 1) * DM, lane);
        FN_ROW(v, row); FN_ROW(v2, row + 1);
    }
    for (int s = wave * G + wg; s < MS; s += 8 * G) {
        load_row(v, nullptr, xb + (size_t)(MP + s) * DM, lane);
        if (fx.S) sample_fix(v, fx, s, xb + (size_t)(MP + s) * DM, lane);
        FN_ROW(v, MP + s);
    }
#undef FN_ROW
}

__device__ __forceinline__ void cumsum_seq(const float* s1, int n1, const float* s2, int n2, float* dst, LAS unsigned char* lds, int tid, int wave, int lane) {
    LAS double* red = (LAS double*)lds;
    const int n = n1 + n2;
    double loc[9]; double run = 0.0;
#pragma unroll
    for (int e = 0; e < 9; ++e) { const int pos = 9 * tid + e; float v = 0.f;
        if (pos < n) v = (pos < n1) ? s1[(size_t)pos * 8] : s2[(size_t)(pos - n1) * 8];
        run += (double)v; loc[e] = run; }
    double x = run;
#pragma unroll
    for (int o = 1; o < 64; o <<= 1) { const double y = __shfl_up(x, o); if (lane >= o) x += y; }
    __syncthreads();
    if (lane == 63) red[wave] = x;
    __syncthreads();
    double pre = x - run;
    for (int w = 0; w < wave; ++w) pre += red[w];
#pragma unroll
    for (int e = 0; e < 9; ++e) { const int pos = 9 * tid + e; if (pos < n) dst[pos] = (float)((pre + loc[e]) * 1.4426950408889634); }
    __syncthreads();
}

namespace att {
constexpr int SHM = 16384;
constexpr int L_V = 0, L_K = 2 * SHM, L_WS = 4 * SHM, L_TAB = L_WS + 2048, L_FK = L_TAB + 1024, L_ACT = L_FK + 512, L_END = L_ACT + 64;
constexpr float THR2 = 11.0f;
#define KSWZ(row, colB) ((row) * 256 + ((colB) ^ (((row) & 7) << 4)))
__device__ __forceinline__ int v_st(int k, int c) { const int kk = k; return ((kk >> 3) * 4 + (c >> 5)) * 512 + ((kk & 7) * 32 + (c & 31)) * 2; }
__device__ __forceinline__ int v_rd_base(int lane) { return ((lane & 3) << 3) | (((lane >> 2) & 3) << 6) | (((lane >> 4) & 1) << 5) | (((lane >> 5) & 1) << 8); }
__device__ __forceinline__ int crow(int r, int hi) { return (r & 3) + 8 * (r >> 2) + 4 * hi; }

struct Args {
    const void* K1; const void* V1; const void* K2; const void* V2;
    const bf16_t* Q; bf16_t* O;
    const float* F;
    const float* tabsrc; int tabkind;
    float* o1s; const float* subg; float lam; float kmax2;
    int ks, qs, os, nrows, qpos0, kpos0, nt, tsplit, band;
};

template <int ND0, bool K128P = false>
__device__ __forceinline__ void qkt(f32x16& p0, f32x16& p1, const f32x16& c0, const f32x16& c1, const LAS unsigned char* Kt, int r32, int hi, const bf16x8 (&qr)[ND0]) {
    p0 = c0; p1 = c1;
    const LAS unsigned char* kb[4];
#pragma unroll
    for (int dd = 0; dd < 4; ++dd) kb[dd] = K128P ? Kt + r32 * 128 + (((dd * 2 + hi) ^ ((r32 >> 1) & 7)) << 4) : Kt + KSWZ(r32, (dd * 16 + hi * 8) * 2);
#pragma unroll
    for (int d0 = 0; d0 < ND0; ++d0) { const LAS unsigned char* a = kb[d0 & 3] + (d0 >> 2) * 128;
        const bf16x8 b0 = *(const LAS bf16x8*)a;
        const bf16x8 b1 = *(const LAS bf16x8*)(a + 32 * (K128P ? 128 : 256));
        p0 = __builtin_amdgcn_mfma_f32_32x32x16_bf16(b0, qr[d0], p0, 0, 0, 0);
        p1 = __builtin_amdgcn_mfma_f32_32x32x16_bf16(b1, qr[d0], p1, 0, 0, 0); }
}
#define TRRD(p) __builtin_amdgcn_ds_read_tr16_b64_v4i16((LAS s16x4*)(p))
__device__ __forceinline__ void pv_tile(f32x16 (&o)[4], const LAS unsigned char* vb, bf16x8 pa0, bf16x8 pa1, bf16x8 pa2, bf16x8 pa3) {
    s16x4 la[4], ha[4], lb[4], hb[4];
#define PV_RD(L, H, ks) _Pragma("unroll") for (int d0 = 0; d0 < 4; ++d0) { L[d0] = TRRD(vb + d0 * 512 + (ks) * 4096); H[d0] = TRRD(vb + d0 * 512 + (ks) * 4096 + 2048); }
#define PV_MM(L, H, pa) _Pragma("unroll") for (int d0 = 0; d0 < 4; ++d0) o[d0] = __builtin_amdgcn_mfma_f32_32x32x16_bf16((bf16x8){L[d0][0], L[d0][1], L[d0][2], L[d0][3], H[d0][0], H[d0][1], H[d0][2], H[d0][3]}, pa, o[d0], 0, 0, 0);
    PV_RD(la, ha, 0) SBAR();
    PV_RD(lb, hb, 1) PV_MM(la, ha, pa0) SBAR();
    PV_RD(la, ha, 2) PV_MM(lb, hb, pa1) SBAR();
    PV_RD(lb, hb, 3) PV_MM(la, ha, pa2) SBAR();
    PV_MM(lb, hb, pa3) SBAR();
#undef PV_RD
#undef PV_MM
}
__device__ __forceinline__ int t5_bucket(int rel) {
    const int n = rel < 0 ? -rel : rel; int b;
    if (n < 8) b = n; else if (n < 12) b = 8; else if (n < 16) b = 9; else if (n < 23) b = 10; else if (n < 32) b = 11; else if (n < 46) b = 12; else if (n < 64) b = 13; else if (n < 91) b = 14; else b = 15;
    return b + (rel > 0 ? 16 : 0);
}

template <bool F32SRC, int DQK, int MODE, bool PRUNE = false>
__device__ __forceinline__ void attn_item(LAS unsigned char* lds, const Args& a, int wave_s) {
    constexpr bool DUAL = F32SRC && DQK == 64;
    constexpr int ND0 = DQK / 16, NPASS = (DQK == 64 && !DUAL) ? 2 : 1;
    constexpr bool KHALF = !F32SRC && DQK == 64;
    const int tid = fresh_tid(wave_s), wave = __builtin_amdgcn_readfirstlane(tid >> 6), lane = tid & 63, r32 = lane & 31, hi = lane >> 5;
    LAS unsigned char* V_lds = lds + L_V; LAS unsigned char* K_lds = lds + L_K;
    LAS float* li_l = (LAS float*)(lds + L_WS) + wave * 64; LAS float* al_l = li_l + 32;
    LAS float* tab = (LAS float*)(lds + L_TAB); LAS float* fk = (LAS float*)(lds + L_FK);
    const int rg = DUAL ? (wave & 1) : wave, hfw = DUAL ? (wave >> 1) : 0;
    const bool wact = DUAL ? (wave < 4) : (wave * 32 < a.nrows);
    const int wq0 = a.qpos0 + rg * 32, cq = wq0 >> 6, qpos = wq0 + r32;
    const int sr = tid >> 4, sc = (tid & 15) * 8;
    const int kws = KSWZ(sr, sc * 2), vst0 = v_st(sr, sc), vst1 = v_st(32 + sr, sc);
    const LAS unsigned char* vb = V_lds + v_rd_base(lane);
    bf16x8 sk0, sk1, sv0, sv1; f32x4 fk0a, fk0b, fk1a, fk1b, fv0a, fv0b, fv1a, fv1b; float ff = 0.f;
    int vdo[2] = {0, 0}, kdo = 0;
    if constexpr (KHALF) {
#pragma unroll
        for (int j = 0; j < 2; ++j) { const int P = (wave * 2 + j) * 64 + lane; const int kr = ((P >> 7) << 3) | ((P >> 2) & 7), c = ((P >> 5) & 3) * 32 + (P & 3) * 8; vdo[j] = kr * a.ks + c; }
        { const int P = wave * 64 + lane, r = P >> 3, c = (P & 7) ^ ((r >> 1) & 7); kdo = r * a.ks + c * 8; }
    }
#define AT_LOAD(t) do { const int t_ = (t); const bool s2_ = t_ >= a.tsplit; const size_t ro_ = (size_t)((s2_ ? t_ - a.tsplit : t_) * 64 + sr) * a.ks + sc; const size_t r32o_ = (size_t)32 * a.ks; \
        if constexpr (F32SRC) { const float* kp_ = (const float*)(s2_ ? a.K2 : a.K1) + ro_; const float* vp_ = (const float*)(s2_ ? a.V2 : a.V1) + ro_; \
            fv0a = *(const f32x4*)vp_; fv0b = *(const f32x4*)(vp_ + 4); fv1a = *(const f32x4*)(vp_ + r32o_); fv1b = *(const f32x4*)(vp_ + r32o_ + 4); \
            fk0a = *(const f32x4*)kp_; fk0b = *(const f32x4*)(kp_ + 4); fk1a = *(const f32x4*)(kp_ + r32o_); fk1b = *(const f32x4*)(kp_ + r32o_ + 4); } \
        else if constexpr (KHALF) { } \
        else { const bf16_t* kp_ = (const bf16_t*)(s2_ ? a.K2 : a.K1) + ro_; const bf16_t* vp_ = (const bf16_t*)(s2_ ? a.V2 : a.V1) + ro_; \
            sv0 = *(const bf16x8*)vp_; sv1 = *(const bf16x8*)(vp_ + r32o_); sk0 = *(const bf16x8*)kp_; sk1 = *(const bf16x8*)(kp_ + r32o_); } \
        if constexpr (MODE == 1) { if (tid < 64) ff = a.F[t_ * 64 + tid]; } } while (0)
#define AT_VDMA(t, bf) do { if constexpr (KHALF) { const int t_ = (t); const bool s2_ = t_ >= a.tsplit; const bf16_t* vb_ = (const bf16_t*)(s2_ ? a.V2 : a.V1) + (size_t)((s2_ ? t_ - a.tsplit : t_) * 64) * a.ks; \
        _Pragma("unroll") for (int j_ = 0; j_ < 2; ++j_) __builtin_amdgcn_global_load_lds((const unsigned*)(vb_ + vdo[j_]), (LAS unsigned*)(V_lds + (bf) * SHM + (wave * 2 + j_) * 1024), 16, 0, 0); \
        const bf16_t* kb_ = (const bf16_t*)(s2_ ? a.K2 : a.K1) + (size_t)((s2_ ? t_ - a.tsplit : t_) * 64) * a.ks + pass * 64; \
        __builtin_amdgcn_global_load_lds((const unsigned*)(kb_ + kdo), (LAS unsigned*)(K_lds + (bf) * SHM + wave * 1024), 16, 0, 0); } } while (0)
#define AT_WRITE(bf) do { const int b_ = (bf); \
        if constexpr (F32SRC) { sk0 = pack8(fk0a, fk0b); sk1 = pack8(fk1a, fk1b); sv0 = pack8(fv0a, fv0b); sv1 = pack8(fv1a, fv1b); } \
        if constexpr (KHALF) { } \
        else { *(LAS bf16x8*)(K_lds + b_ * SHM + kws) = sk0; *(LAS bf16x8*)(K_lds + b_ * SHM + kws + 32 * 256) = sk1; } \
        if constexpr (!KHALF) { *(LAS bf16x8*)(V_lds + b_ * SHM + vst0) = sv0; *(LAS bf16x8*)(V_lds + b_ * SHM + vst1) = sv1; } \
        if constexpr (MODE == 1) { if (tid < 64) fk[b_ * 64 + tid] = -ff; } } while (0)

    for (int pass = 0; pass < NPASS; ++pass) {
        bf16x8 qr[ND0];
#pragma unroll
        for (int d0 = 0; d0 < ND0; ++d0) qr[d0] = wact ? *(const bf16x8*)(a.Q + (size_t)(rg * 32 + r32) * a.qs + (DUAL ? hfw : pass) * 64 + d0 * 16 + hi * 8) : bf16x8{};
        float m_reg = -1e30f, l_reg = 0.f; f32x16 o[4];
#pragma unroll
        for (int d0 = 0; d0 < 4; ++d0) o[d0] = f32x16{};
        f32x16 cfar = f32x16{}; bool cdirty = true;
        float sbound = 0.f; bool wdone = false;
        if constexpr (PRUNE) {
            float qq = 0.f;
#pragma unroll
            for (int d0 = 0; d0 < ND0; ++d0)
#pragma unroll
                for (int e = 0; e < 8; ++e) { const float x = __uint_as_float(((unsigned)(unsigned short)qr[d0][e]) << 16); qq += x * x; }
            { auto rr = __builtin_amdgcn_permlane32_swap(__float_as_uint(qq), __float_as_uint(qq), false, false); qq = __uint_as_float(rr[0]) + __uint_as_float(rr[1]); }
#pragma unroll
            for (int x = 1; x < 32; x <<= 1) qq = fmaxf(qq, __shfl_xor(qq, x));
            sbound = sqrtf(qq * a.kmax2) * 1.02f + 0.5f;
            LAS int* actf = (LAS int*)(lds + L_ACT);
            if (tid < 16) actf[tid] = 0;
        }
#define AT_TILE(i_) (PRUNE ? (a.nt - 1 - (i_)) : (i_))
        AT_LOAD(AT_TILE(0)); AT_VDMA(AT_TILE(0), 0);
        if constexpr (MODE == 0) {
            if (pass == 0 && tid < 256) { int rel = tid - 192; if (rel < -128) rel = -128; float v;
                if (a.tabkind == 0) v = a.tabsrc[t5_bucket(rel) * 8]; else v = a.tabsrc[(rel + 128) * 16];
                tab[tid] = v * LOG2E; }
        }
        AT_WRITE(0);
        __syncthreads();
        if (wave >= 4) __builtin_amdgcn_s_setprio(1);
        for (int it = 0; it < a.nt; ++it) {
            const int buf = it & 1, t = AT_TILE(it);
            if (it + 1 < a.nt) { AT_LOAD(AT_TILE(it + 1)); AT_VDMA(AT_TILE(it + 1), buf ^ 1); }
            SBAR();
            const int kb = a.kpos0 + 64 * t;
            bool act;
            if constexpr (MODE == 0) { const int kc = kb >> 6; act = wact && (kc <= cq) && (kc >= cq - a.band); }
            else act = wact && (kb <= wq0 + 31);
            if constexpr (PRUNE) {
                if (act && !wdone) {
                    float mm = m_reg;
#pragma unroll
                    for (int x = 1; x < 32; x <<= 1) mm = fminf(mm, __shfl_xor(mm, x));
                    const float btile = fk[buf * 64 + 63];
                    if (__all(mm > -1e29f && sbound + btile - mm < -40.0f)) wdone = true;
                }
                act = act && !wdone;
            }
            if (act) {
                f32x16 p0, p1; float alpha = 1.f, ps = 0.f;
                if constexpr (F32SRC) {
                                { const f32x16 z = f32x16{}; qkt<ND0>(p0, p1, z, z, K_lds + buf * SHM + (DUAL ? hfw : pass) * 128, r32, hi, qr); }
                float cb = 0.f;
                if constexpr (MODE == 0) {
                    if (kb - wq0 + 191 <= 0) cb = tab[0];
                    else { const LAS float* tp = tab + (kb - qpos + 4 * hi + 192);
#pragma unroll
                        for (int r = 0; r < 16; ++r) { const int c = (r & 3) + 8 * (r >> 2); p0[r] += tp[c]; p1[r] += tp[c + 32]; } }
                } else {
                    const LAS f32x4* f4 = (const LAS f32x4*)(fk + buf * 64);
#pragma unroll
                    for (int j = 0; j < 4; ++j) { const f32x4 fa = f4[2 * j + hi], fb = f4[8 + 2 * j + hi];
#pragma unroll
                        for (int e = 0; e < 4; ++e) { p0[4 * j + e] += fa[e]; p1[4 * j + e] += fb[e]; } }
                    if (kb + 63 > wq0) { const int dq = qpos - kb - 4 * hi; const float NEG = -__builtin_inff();
#pragma unroll
                        for (int r = 0; r < 16; ++r) { const int c = (r & 3) + 8 * (r >> 2); if (c > dq) p0[r] = NEG; if (c + 32 > dq) p1[r] = NEG; } }
                }
                float pmax = p0[0];
#pragma unroll
                for (int r = 1; r < 16; ++r) pmax = fmaxf(pmax, p0[r]);
#pragma unroll
                for (int r = 0; r < 16; ++r) pmax = fmaxf(pmax, p1[r]);
                { auto rr = __builtin_amdgcn_permlane32_swap(__float_as_uint(pmax), __float_as_uint(pmax), false, false);
                  pmax = fmaxf(__uint_as_float(rr[0]), __uint_as_float(rr[1])) + cb; }
                float mn;
                if (__all((pmax - m_reg) <= THR2)) { mn = m_reg; }
                else { mn = fmaxf(m_reg, pmax); alpha = __builtin_amdgcn_exp2f(m_reg - mn); m_reg = mn; }
                const float mnc = mn - cb;
#pragma unroll
                for (int r = 0; r < 16; ++r) { p0[r] = __builtin_amdgcn_exp2f(p0[r] - mnc); p1[r] = __builtin_amdgcn_exp2f(p1[r] - mnc); ps += p0[r] + p1[r]; }
                { auto rr = __builtin_amdgcn_permlane32_swap(__float_as_uint(ps), __float_as_uint(ps), false, false);
                  ps = __uint_as_float(rr[0]) + __uint_as_float(rr[1]); }
                } else {
                const bool fl = m_reg < -1e29f; const float mref = fl ? 0.f : m_reg;
#define AT_BIAS(D0, D1, OP) do { \
                if constexpr (MODE == 0) { \
                    if (kb - wq0 + 191 <= 0) { const float nb = tab[0] - mref; \
                        _Pragma("unroll") for (int r = 0; r < 16; ++r) { D0[r] OP nb; D1[r] OP nb; } } \
                    else { const LAS float* tp = tab + (kb - qpos + 4 * hi + 192); \
                        _Pragma("unroll") for (int r = 0; r < 16; ++r) { const int c = (r & 3) + 8 * (r >> 2); D0[r] OP tp[c] - mref; D1[r] OP tp[c + 32] - mref; } } \
                } else { \
                    const LAS f32x4* f4 = (const LAS f32x4*)(fk + buf * 64); \
                    _Pragma("unroll") for (int j = 0; j < 4; ++j) { const f32x4 fa = f4[2 * j + hi], fb = f4[8 + 2 * j + hi]; \
                        _Pragma("unroll") for (int e = 0; e < 4; ++e) { D0[4 * j + e] OP fa[e] - mref; D1[4 * j + e] OP fb[e] - mref; } } \
                } } while (0)
                if (MODE == 0 && kb - wq0 + 191 <= 0) {
                    if constexpr (KHALF) {
                        if (cdirty) { const float nb = tab[0] - mref;
#pragma unroll
                            for (int r = 0; r < 16; ++r) cfar[r] = nb;
                            cdirty = false; }
                        qkt<ND0, KHALF>(p0, p1, cfar, cfar, K_lds + buf * SHM, r32, hi, qr);
                    } else {
                    f32x16 c; const float nb = tab[0] - mref;
#pragma unroll
                    for (int r = 0; r < 16; ++r) c[r] = nb;
                    qkt<ND0, KHALF>(p0, p1, c, c, K_lds + buf * SHM + (KHALF ? 0 : (DUAL ? hfw : pass) * 128), r32, hi, qr); }
                } else { f32x16 c0, c1; AT_BIAS(c0, c1, =); qkt<ND0, KHALF>(p0, p1, c0, c1, K_lds + buf * SHM + (KHALF ? 0 : (DUAL ? hfw : pass) * 128), r32, hi, qr); }
#undef AT_BIAS
                if constexpr (MODE == 1) {
                    if (kb + 63 > wq0) { const int dq = qpos - kb - 4 * hi; const float NEG = -__builtin_inff();
#pragma unroll
                        for (int r = 0; r < 16; ++r) { const int c = (r & 3) + 8 * (r >> 2); if (c > dq) p0[r] = NEG; if (c + 32 > dq) p1[r] = NEG; } }
                }
                float pmax = p0[0];
#pragma unroll
                for (int r = 1; r < 16; ++r) pmax = fmaxf(pmax, p0[r]);
#pragma unroll
                for (int r = 0; r < 16; ++r) pmax = fmaxf(pmax, p1[r]);
                float d = 0.f;
                const bool common = __all(!fl && pmax <= THR2);
                if (!common) { { auto rr = __builtin_amdgcn_permlane32_swap(__float_as_uint(pmax), __float_as_uint(pmax), false, false);
                                 pmax = fmaxf(__uint_as_float(rr[0]), __uint_as_float(rr[1])); }
                    d = fl ? fmaxf(pmax, -1e30f) : fmaxf(pmax, 0.f); alpha = fl ? 1.f : __builtin_amdgcn_exp2f(-d); m_reg = mref + d; cdirty = true; }
                if (common) {
#pragma unroll
                    for (int r = 0; r < 16; ++r) { p0[r] = __builtin_amdgcn_exp2f(p0[r]); p1[r] = __builtin_amdgcn_exp2f(p1[r]); ps += p0[r] + p1[r]; }
                } else {
#pragma unroll
                    for (int r = 0; r < 16; ++r) { p0[r] = __builtin_amdgcn_exp2f(p0[r] - d); p1[r] = __builtin_amdgcn_exp2f(p1[r] - d); ps += p0[r] + p1[r]; }
                }
                }
                l_reg = l_reg * alpha + ps;
                bf16x8 pa0, pa1, pa2, pa3;
#define PK4(P, B_, OUT) do { u32x4 w = {cvtpk(P[B_+0], P[B_+1]), cvtpk(P[B_+2], P[B_+3]), cvtpk(P[B_+4], P[B_+5]), cvtpk(P[B_+6], P[B_+7])}; OUT = *reinterpret_cast<bf16x8*>(&w); } while (0)
                PK4(p0, 0, pa0); PK4(p0, 8, pa1); PK4(p1, 0, pa2); PK4(p1, 8, pa3);
#undef PK4
                if (__any(alpha < 1.f)) {
#pragma unroll
                    for (int d0 = 0; d0 < 4; ++d0)
#pragma unroll
                        for (int r = 0; r < 16; ++r) o[d0][r] *= alpha; }
                pv_tile(o, vb + buf * SHM, pa0, pa1, pa2, pa3);
            }
            SBAR();
            if (it + 1 < a.nt) AT_WRITE(buf ^ 1);
            if constexpr (PRUNE) { if (lane == 0) ((LAS int*)(lds + L_ACT))[buf * 8 + wave] = (wact && !wdone) ? 1 : 0; }
            __syncthreads();
            if constexpr (PRUNE) { const LAS int* af = (const LAS int*)(lds + L_ACT) + buf * 8; int any = 0;
#pragma unroll
                for (int w = 0; w < 8; ++w) any |= af[w];
                if (!any) break; }
        }
#undef AT_TILE
        __builtin_amdgcn_s_setprio(0);
        if constexpr (!F32SRC) { auto rr = __builtin_amdgcn_permlane32_swap(__float_as_uint(l_reg), __float_as_uint(l_reg), false, false); l_reg = __uint_as_float(rr[0]) + __uint_as_float(rr[1]); }
        const float rl = __builtin_amdgcn_rcpf(l_reg);
#define AT_STORE_ROW(OROW, VAL) do { _Pragma("unroll") for (int d0 = 0; d0 < 4; ++d0) _Pragma("unroll") for (int k = 0; k < 2; ++k) { \
            unsigned x0 = cvtpk(VAL(d0, 8 * k + 0), VAL(d0, 8 * k + 1)), x1 = cvtpk(VAL(d0, 8 * k + 2), VAL(d0, 8 * k + 3)); \
            unsigned y0 = cvtpk(VAL(d0, 8 * k + 4), VAL(d0, 8 * k + 5)), y1 = cvtpk(VAL(d0, 8 * k + 6), VAL(d0, 8 * k + 7)); \
            auto s0 = __builtin_amdgcn_permlane32_swap(x0, y0, false, false); auto s1 = __builtin_amdgcn_permlane32_swap(x1, y1, false, false); \
            u32x4 w = {s0[0], s1[0], s0[1], s1[1]}; \
            int oo = d0 * 32 + 16 * k + 8 * hi; asm volatile("" : "+v"(oo)); \
            *(u32x4*)((OROW) + oo) = w; } } while (0)
        if constexpr (DUAL) {
            LAS float* X = (LAS float*)(lds + 73728);
            if (wact && hfw == 1) {
#pragma unroll
                for (int r = 0; r < 16; ++r)
#pragma unroll
                    for (int d0 = 0; d0 < 4; ++d0) X[(rg * 64 + r * 4 + d0) * 64 + lane] = o[d0][r] * rl;
            }
            __syncthreads();
            if (wact && hfw == 0) {
                float ssq = 0.f;
#pragma unroll
                for (int r = 0; r < 16; ++r)
#pragma unroll
                    for (int d0 = 0; d0 < 4; ++d0) { const float v = o[d0][r] * rl - a.lam * X[(rg * 64 + r * 4 + d0) * 64 + lane]; o[d0][r] = v; ssq += v * v; }
                { auto rr = __builtin_amdgcn_permlane32_swap(__float_as_uint(ssq), __float_as_uint(ssq), false, false); ssq = __uint_as_float(rr[0]) + __uint_as_float(rr[1]); }
                const float rs = 0.8f * __builtin_amdgcn_rsqf(ssq * (1.0f / 128.0f) + EPS);
                bf16_t* orow = a.O + (size_t)(rg * 32 + r32) * a.os;
                const float* gp = a.subg + 4 * hi;
#pragma unroll
                for (int d0 = 0; d0 < 4; ++d0)
#pragma unroll
                    for (int g = 0; g < 4; ++g) { const f32x4 gg = *(const f32x4*)(gp + d0 * 32 + 8 * g);
#pragma unroll
                        for (int e = 0; e < 4; ++e) o[d0][4 * g + e] *= rs * gg[e]; }
#define AT_VAL(d0_, r_) o[d0_][r_]
                AT_STORE_ROW(orow, AT_VAL);
#undef AT_VAL
            }
        } else
        if (wact) {
            if (DQK == 64 && pass == 0) {
#pragma unroll
                for (int r = 0; r < 16; ++r) {
                    int so = wave * 4096 + r * 256 + lane; asm volatile("" : "+v"(so));
                    float* sp = a.o1s + so;
#pragma unroll
                    for (int d0 = 0; d0 < 4; ++d0) sp[d0 * 64] = o[d0][r] * rl; }
                VM_WAIT();
            } else {
                bf16_t* orow = a.O + (size_t)(wave * 32 + r32) * a.os;
                if constexpr (DQK == 64) {
                    float ssq = 0.f;
#pragma unroll
                    for (int r = 0; r < 16; ++r) {
                        int so = wave * 4096 + r * 256 + lane; asm volatile("" : "+v"(so));
                        const float* sp = a.o1s + so;
#pragma unroll
                        for (int d0 = 0; d0 < 4; ++d0) { const float o1 = __hip_atomic_load(sp + d0 * 64, __ATOMIC_RELAXED, __HIP_MEMORY_SCOPE_AGENT);
                            const float v = o1 - a.lam * (o[d0][r] * rl); o[d0][r] = v; ssq += v * v; } }
                    { auto rr = __builtin_amdgcn_permlane32_swap(__float_as_uint(ssq), __float_as_uint(ssq), false, false); ssq = __uint_as_float(rr[0]) + __uint_as_float(rr[1]); }
                    const float rs = 0.8f * __builtin_amdgcn_rsqf(ssq * (1.0f / 128.0f) + EPS);
                    const float* gp = a.subg + 4 * hi;
#pragma unroll
                    for (int d0 = 0; d0 < 4; ++d0)
#pragma unroll
                        for (int g = 0; g < 4; ++g) { const f32x4 gg = *(const f32x4*)(gp + d0 * 32 + 8 * g);
#pragma unroll
                            for (int e = 0; e < 4; ++e) o[d0][4 * g + e] *= rs * gg[e]; }
                } else {
#pragma unroll
                    for (int d0 = 0; d0 < 4; ++d0)
#pragma unroll
                        for (int r = 0; r < 16; ++r) o[d0][r] *= rl;
                }
#define AT_VAL(d0_, r_) o[d0_][r_]
                AT_STORE_ROW(orow, AT_VAL);
#undef AT_VAL
            }
        }
#undef AT_STORE_ROW
        __syncthreads();
    }
#undef AT_LOAD
#undef AT_WRITE
#undef AT_VDMA
}
}

struct KArgs { InPtrs in; float* out; unsigned char* ws; int ph_lo, ph_hi; };

#define Q_PRE() unsigned nx_ = 0u; if (tid == 0) nx_ = __hip_atomic_fetch_add(qw, 1u, __ATOMIC_RELAXED, __HIP_MEMORY_SCOPE_AGENT)
__device__ __forceinline__ int q_post(unsigned nx, volatile LAS unsigned* slot, int tid) {
    if (tid == 0) *slot = nx;
    __syncthreads();
    return (int)*slot;
}
__device__ __forceinline__ int q_next(unsigned* qw, volatile LAS unsigned* slot, int tid) {
    __syncthreads();
    if (tid == 0) *slot = __hip_atomic_fetch_add(qw, 1u, __ATOMIC_RELAXED, __HIP_MEMORY_SCOPE_AGENT);
    __syncthreads();
    return (int)*slot;
}

__device__ __forceinline__ void sample_qkv_finalize(const float* part, int b, int colq, int colk, int colv, float qscale, bf16_t* BIG, float* outK, float* outV, int ldf, int hcol, int tid) {
    for (int i = tid; i < 3 * 64 * 16; i += 512) {
        const int sec3 = i >> 10, r = (i & 1023) >> 4, c8 = (i & 15) * 8;
        const int col = (sec3 == 0 ? colq : (sec3 == 1 ? colk : colv)) + c8;
        const float* pp = part + ((size_t)(b * 64 + r)) * NQKV + col;
        f32x4 s0 = {0.f, 0.f, 0.f, 0.f}, s1 = {0.f, 0.f, 0.f, 0.f};
#pragma unroll
        for (int sl = 0; sl < 5; ++sl) { s0 += *(const f32x4*)(pp + (size_t)sl * MS * NQKV); s1 += *(const f32x4*)(pp + (size_t)sl * MS * NQKV + 4); }
        if (sec3 == 1) { float* d = outK + (size_t)(b * 64 + r) * ldf + hcol + c8; *(f32x4*)d = s0; *(f32x4*)(d + 4) = s1; }
        if (sec3 == 2) { float* d = outV + (size_t)(b * 64 + r) * ldf + hcol + c8; *(f32x4*)d = s0; *(f32x4*)(d + 4) = s1; }
        const float sc = sec3 == 0 ? qscale : 1.0f;
        u32x4 w; w.x = cvtpk(s0[0] * sc, s0[1] * sc); w.y = cvtpk(s0[2] * sc, s0[3] * sc); w.z = cvtpk(s1[0] * sc, s1[1] * sc); w.w = cvtpk(s1[2] * sc, s1[3] * sc);
        *(u32x4*)(BIG + (size_t)(MP + b * 64 + r) * NQKV + col) = w;
    }
    VM_WAIT(); __syncthreads();
}

template <int l>
__device__ __forceinline__ void layer_phases(LAS unsigned char* lds, unsigned char* ws, float* out, unsigned* ctl, const XcdBarrier& bar, int G, int wg, int wave0, int lo, int hi_, int& phase) {
    volatile LAS unsigned* MISC = (volatile LAS unsigned*)(lds + MISC_OFF);
    bf16_t* H = (bf16_t*)(ws + WS_H); bf16_t* BIG = (bf16_t*)(ws + WS_BIG); bf16_t* ATT = (bf16_t*)(ws + WS_ATT); bf16_t* XB = (bf16_t*)(ws + WS_XB);
    float* mods = (float*)(ws + WS_MODS);
#define PH_BEGIN if (phase >= lo && phase < hi_) { const int tid = fresh_tid(wave0), lane = tid & 63, wave = __builtin_amdgcn_readfirstlane(tid >> 6); (void)lane; (void)wave;
#define PH_END   if (MK_N_LAUNCHES == 1) xcd_barrier(bar, fresh_tid(wave0)); } ++phase;
#define MODS_L (mods + (size_t)l * 16 * NADA)
#define NG_L (inp(lds, 13) + (size_t)l * 3 * DM)
        PH_BEGIN { if (EN(2)) { norm_phase<false>((l == 0) ? inp(lds, 0) : nullptr, (l == 0) ? inp(lds, 1) : nullptr, XB, NG_L, MODS_L, 0, H, nullptr, nullptr, out, SampleFix{(const float*)(ws + WS_PART), (l == 0) ? 0 : 15, mods + 8 * DM, 0.5f}, lds, G, wg, tid, wave, lane); } } PH_END
        PH_BEGIN { pg8::Gemm g{H, (const bf16_t*)(ws + WS_WFI + (size_t)(l * 2 + 0) * SZ_WFI), MROWS, 11008, DM}; pg8::StaticOrder S; S.init(MROWS, 11008, G, wg); S.ntk = DM / 64;
            EpiSwiGLU E{BIG}; { if (EN(6)) { pg8::gemm_phase<EpiSwiGLU, pg8::StaticOrder, true, true>(lds, g, S, E, wave0); } } } PH_END
        PH_BEGIN { pg8::Gemm g{BIG, (const bf16_t*)(ws + WS_WFO + (size_t)(l * 2 + 0) * SZ_WFO), MROWS, DM, DFF}; pg8::SplitOrder S; S.init(DFF, DM, 15, G, wg);
            EpiResGate E{(l == 0) ? inp(lds, 0) : nullptr, XB, MODS_L + 2 * DM, 0.5f, (float*)(ws + WS_PART)}; { if (EN(7)) { pg8::gemm_phase<EpiResGate, pg8::SplitOrder, true, true>(lds, g, S, E, wave0); } } } PH_END
        PH_BEGIN if (l == 0) { if (EN(3)) { norm_phase<true>(nullptr, inp(lds, 1), XB, NG_L + DM, MODS_L, 3, H, inp(lds, 16), inp(lds, 17), out, SampleFix{(const float*)(ws + WS_PART), 15, MODS_L + 2 * DM, 0.5f}, lds, G, wg, tid, wave, lane); } }
                 else { if (EN(2)) { norm_phase<false>(nullptr, nullptr, XB, NG_L + DM, MODS_L, 3, H, nullptr, nullptr, out, SampleFix{(const float*)(ws + WS_PART), 15, MODS_L + 2 * DM, 0.5f}, lds, G, wg, tid, wave, lane); } } PH_END
        PH_BEGIN {
            if (l == 0 && wg < 128) {
                const int s = wg & 63, b = s >> 3, hh = s & 7;
                const bool smp = wg >= 64;
                const float* s1 = smp ? inp(lds, 6) + (size_t)b * PAST * 8 + hh : out + OFF_BFP + (size_t)b * SEQ * 8 + hh;
                const float* s2 = out + OFF_BFS + (size_t)b * DSEQ * 8 + hh;
                float* dst = smp ? (float*)(ws + WS_FS) + (size_t)s * (PAST + DSEQ) : (float*)(ws + WS_FP) + (size_t)s * SEQ;
                { if (EN(5)) { cumsum_seq(s1, SEQ, s2, smp ? DSEQ : 0, dst, lds, tid, wave, lane); } }
            }
            pg8::Gemm g{H, (const bf16_t*)(ws + (l == 0 ? WS_WINAB : WS_WINC)), MROWS, NQKV, DM}; pg8::SplitOrder S; S.init(DM, NQKV, 5, G, wg);
            EpiQKV E{BIG, out, l, (float*)(ws + WS_PART)};
            { if (EN(8)) { pg8::gemm_phase<EpiQKV, pg8::SplitOrder, true, true>(lds, g, S, E, wave0); } } } PH_END
        PH_BEGIN {
            att::Args a; a.o1s = (float*)(ws + WS_O1) + (size_t)wg * 32768; a.subg = inp(lds, 23); a.lam = 0.f; a.kmax2 = 0.f; a.F = nullptr; a.tabsrc = nullptr; a.tabkind = 0; a.band = 1 << 20;
            if (l == 0) {
                { float v1 = (lane < 64) ? inp(lds, 19)[lane] * inp(lds, 20)[lane] : 0.f, v2 = inp(lds, 21)[lane] * inp(lds, 22)[lane];
                  a.lam = expf(wave_sum(v1)) - expf(wave_sum(v2)) + 0.2f; }
                for (int u = wg; u < 256; u += G) {
                    const int s = u >> 2, b = s >> 3, h = s & 7;
                    const bf16_t* kp = BIG + (size_t)(b * SEQ + (u & 3) * 1024 + (tid >> 4)) * NQKV + 4096 + h * 128 + (tid & 15) * 8;
                    float mx = 0.f;
#pragma unroll 4
                    for (int i = 0; i < 32; ++i) { const bf16x8 v = *(const bf16x8*)(kp + (size_t)(32 * i) * NQKV); float ss = 0.f;
#pragma unroll
                        for (int e = 0; e < 8; ++e) { const float x = __uint_as_float(((unsigned)(unsigned short)v[e]) << 16); ss += x * x; }
                        ss += __shfl_xor(ss, 1); ss += __shfl_xor(ss, 2); ss += __shfl_xor(ss, 4); ss += __shfl_xor(ss, 8);
                        mx = fmaxf(mx, ss); }
                    mx = fmaxf(mx, __shfl_xor(mx, 16)); mx = fmaxf(mx, __shfl_xor(mx, 32));
                    if (lane == 0) __hip_atomic_fetch_max(ctl + CW_KMX + s, __float_as_uint(mx), __ATOMIC_RELAXED, __HIP_MEMORY_SCOPE_AGENT);
                }
                VM_WAIT(); __syncthreads();
                if (tid == 0) __hip_atomic_fetch_add(ctl + CW_KDONE, 1u, __ATOMIC_RELAXED, __HIP_MEMORY_SCOPE_AGENT);
                unsigned* qw = ctl + CW_Q0;
                int idx = q_next(qw, MISC + 12, tid);
                while (idx < 64) { Q_PRE(); const int b = idx >> 3, h = idx & 7;
                    a.K1 = inp(lds, 2) + ((size_t)b * PAST * 8 + h) * 128; a.V1 = inp(lds, 3) + ((size_t)b * PAST * 8 + h) * 128;
                    a.K2 = out + OFF_AKS + ((size_t)b * DSEQ * 8 + h) * 128; a.V2 = out + OFF_AVS + ((size_t)b * DSEQ * 8 + h) * 128; a.ks = 1024;
                    a.Q = BIG + (size_t)(MP + b * DSEQ) * NQKV + h * 128; a.qs = NQKV; a.O = ATT + (size_t)(MP + b * DSEQ) * DM + h * 128; a.os = DM;
                    a.nrows = 64; a.qpos0 = PAST; a.kpos0 = 0; a.nt = 65; a.tsplit = 64; a.tabsrc = inp(lds, 24) + h; a.tabkind = 0;
                    sample_qkv_finalize((const float*)(ws + WS_PART), b, h * 128, 1024 + h * 128, 2048 + h * 128, 1.0f, BIG, out + OFF_AKS, out + OFF_AVS, 1024, h * 128, tid);
                    { if (EN(9)) { att::attn_item<true, 64, 0>(lds, a, wave0); } } idx = q_post(nx_, MISC + 12 + (idx & 1), tid); }
                while (idx < 128) { Q_PRE(); const int s = idx - 64, b = s >> 3, h = s & 7;
                    a.K1 = inp(lds, 4) + ((size_t)b * PAST * 8 + h) * 128; a.V1 = inp(lds, 5) + ((size_t)b * PAST * 8 + h) * 128;
                    a.K2 = out + OFF_BKS + ((size_t)b * DSEQ * 8 + h) * 128; a.V2 = out + OFF_BVS + ((size_t)b * DSEQ * 8 + h) * 128; a.ks = 1024;
                    a.Q = BIG + (size_t)(MP + b * DSEQ) * NQKV + 3072 + h * 128; a.qs = NQKV; a.O = ATT + (size_t)(MP + b * DSEQ) * DM + 1024 + h * 128; a.os = DM;
                    a.nrows = 64; a.qpos0 = PAST; a.kpos0 = 0; a.nt = 65; a.tsplit = 64; a.F = (const float*)(ws + WS_FS) + (size_t)s * (PAST + DSEQ);
                    sample_qkv_finalize((const float*)(ws + WS_PART), b, 3072 + h * 128, 4096 + h * 128, 5120 + h * 128, 1.0f, BIG, out + OFF_BKS, out + OFF_BVS, 1024, h * 128, tid);
                    { if (EN(10)) { att::attn_item<true, 128, 1>(lds, a, wave0); } } idx = q_post(nx_, MISC + 12 + (idx & 1), tid); }
                while (idx < 128 + 1024) { Q_PRE(); const int p = idx - 128, j = 15 - (p >> 6), s = p & 63, b = s >> 3, h = s & 7;
                    const bf16_t* base = BIG + (size_t)(b * SEQ) * NQKV + h * 128;
                    a.K1 = base + 1024; a.V1 = base + 2048; a.K2 = a.K1; a.V2 = a.V1; a.ks = NQKV;
                    a.Q = base + (size_t)(256 * j) * NQKV; a.qs = NQKV; a.O = ATT + (size_t)(b * SEQ + 256 * j) * DM + h * 128; a.os = DM;
                    a.nrows = 256; a.qpos0 = 256 * j; a.kpos0 = 0; a.nt = 4 * (j + 1); a.tsplit = 1 << 20; a.tabsrc = inp(lds, 24) + h; a.tabkind = 0;
                    { if (EN(11)) { att::attn_item<false, 64, 0>(lds, a, wave0); } } idx = q_post(nx_, MISC + 12 + (idx & 1), tid); }
                if (idx < 128 + 2048) {
                    if (tid == 0) { unsigned sp = 0; while (__hip_atomic_load(ctl + CW_KDONE, __ATOMIC_RELAXED, __HIP_MEMORY_SCOPE_AGENT) < (unsigned)G) { __builtin_amdgcn_s_sleep(2); if (++sp > (1u << 22)) break; } }
                    __syncthreads();
                }
                while (idx < 128 + 2048) { Q_PRE(); const int p = idx - 128 - 1024, j = 15 - (p >> 6), s = p & 63, b = s >> 3, h = s & 7;
                    const bf16_t* base = BIG + (size_t)(b * SEQ) * NQKV + h * 128;
                    a.K1 = base + 4096; a.V1 = base + 5120; a.K2 = a.K1; a.V2 = a.V1; a.ks = NQKV;
                    a.Q = base + 3072 + (size_t)(256 * j) * NQKV; a.qs = NQKV; a.O = ATT + (size_t)(b * SEQ + 256 * j) * DM + 1024 + h * 128; a.os = DM;
                    a.nrows = 256; a.qpos0 = 256 * j; a.kpos0 = 0; a.nt = 4 * (j + 1); a.tsplit = 1 << 20; a.F = (const float*)(ws + WS_FP) + (size_t)s * SEQ;
                    a.kmax2 = __uint_as_float(__hip_atomic_load(ctl + CW_KMX + s, __ATOMIC_RELAXED, __HIP_MEMORY_SCOPE_AGENT));
                    { if (EN(12)) { att::attn_item<false, 128, 1, true>(lds, a, wave0); } } idx = q_post(nx_, MISC + 12 + (idx & 1), tid); }
            } else {
                unsigned* qw = ctl + CW_Q1;
                int idx = q_next(qw, MISC + 12, tid);
                a.band = 8; a.tabkind = 1;
                while (idx < 128) { Q_PRE(); const int b = idx >> 4, h = idx & 15;
                    a.K1 = inp(lds, 7) + ((size_t)b * 512 * 16 + h) * 128; a.V1 = inp(lds, 8) + ((size_t)b * 512 * 16 + h) * 128;
                    a.K2 = out + OFF_CKS + ((size_t)b * DSEQ * 16 + h) * 128; a.V2 = out + OFF_CVS + ((size_t)b * DSEQ * 16 + h) * 128; a.ks = 2048;
                    a.Q = BIG + (size_t)(MP + b * DSEQ) * NQKV + h * 128; a.qs = NQKV; a.O = ATT + (size_t)(MP + b * DSEQ) * DM + h * 128; a.os = DM;
                    a.nrows = 64; a.qpos0 = PAST; a.kpos0 = PAST - 512; a.nt = 9; a.tsplit = 8; a.tabsrc = inp(lds, 27) + h;
                    sample_qkv_finalize((const float*)(ws + WS_PART), b, h * 128, 2048 + h * 128, 4096 + h * 128, 1.0f, BIG, out + OFF_CKS, out + OFF_CVS, 2048, h * 128, tid);
                    { if (EN(13)) { att::attn_item<true, 128, 0>(lds, a, wave0); } } idx = q_post(nx_, MISC + 12 + (idx & 1), tid); }
                while (idx < 128 + 2048) { Q_PRE(); const int p = idx - 128, j = 15 - (p >> 7), s = p & 127, b = s >> 4, h = s & 15;
                    const int c0 = (4 * j - 8) > 0 ? (4 * j - 8) : 0;
                    const bf16_t* base = BIG + (size_t)(b * SEQ) * NQKV + h * 128;
                    a.K1 = base + 2048 + (size_t)(64 * c0) * NQKV; a.V1 = base + 4096 + (size_t)(64 * c0) * NQKV; a.K2 = a.K1; a.V2 = a.V1; a.ks = NQKV;
                    a.Q = base + (size_t)(256 * j) * NQKV; a.qs = NQKV; a.O = ATT + (size_t)(b * SEQ + 256 * j) * DM + h * 128; a.os = DM;
                    a.nrows = 256; a.qpos0 = 256 * j; a.kpos0 = 64 * c0; a.nt = 4 * j + 4 - c0; a.tsplit = 1 << 20; a.tabsrc = inp(lds, 27) + h;
                    { if (EN(14)) { att::attn_item<false, 128, 0>(lds, a, wave0); } } idx = q_post(nx_, MISC + 12 + (idx & 1), tid); }
            }
        } PH_END
        PH_BEGIN { pg8::Gemm g{ATT, (const bf16_t*)(ws + (l == 0 ? WS_WOUTAB : WS_WOUTC)), MROWS, DM, DM}; pg8::SplitOrder S; S.init(DM, DM, 8, G, wg);
            EpiResGate E{nullptr, XB, MODS_L + 5 * DM, 1.0f, (float*)(ws + WS_PART)}; { if (EN(7)) { pg8::gemm_phase<EpiResGate, pg8::SplitOrder, true, true>(lds, g, S, E, wave0); } } } PH_END
        PH_BEGIN { if (EN(2)) { norm_phase<false>(nullptr, nullptr, XB, NG_L + 2 * DM, MODS_L, 6, H, nullptr, nullptr, out, SampleFix{(const float*)(ws + WS_PART), 8, MODS_L + 5 * DM, 1.0f}, lds, G, wg, tid, wave, lane); } } PH_END
        PH_BEGIN { pg8::Gemm g{H, (const bf16_t*)(ws + WS_WFI + (size_t)(l * 2 + 1) * SZ_WFI), MROWS, 11008, DM}; pg8::StaticOrder S; S.init(MROWS, 11008, G, wg); S.ntk = DM / 64;
            EpiSwiGLU E{BIG}; { if (EN(6)) { pg8::gemm_phase<EpiSwiGLU, pg8::StaticOrder, true, true>(lds, g, S, E, wave0); } } } PH_END
        PH_BEGIN { pg8::Gemm g{BIG, (const bf16_t*)(ws + WS_WFO + (size_t)(l * 2 + 1) * SZ_WFO), MROWS, DM, DFF}; pg8::SplitOrder S; S.init(DFF, DM, 15, G, wg);
            EpiResGate E{nullptr, XB, MODS_L + 8 * DM, 0.5f, (float*)(ws + WS_PART)}; { if (EN(7)) { pg8::gemm_phase<EpiResGate, pg8::SplitOrder, true, true>(lds, g, S, E, wave0); } } } PH_END
#undef PH_BEGIN
#undef PH_END
}

__global__ void __launch_bounds__(512, 2) mega_fwd(KArgs args) {
    extern __shared__ __attribute__((aligned(16))) unsigned char lds_raw[];
    LAS unsigned char* lds = (LAS unsigned char*)lds_raw;
    volatile LAS unsigned* MISC = (volatile LAS unsigned*)(lds + MISC_OFF);
    const int tid0 = threadIdx.x;
    const int wave0 = __builtin_amdgcn_readfirstlane(tid0 >> 6);
    const int G = gridDim.x, wg = blockIdx.x;
    unsigned char* ws = args.ws; float* out = args.out;
    unsigned* ctl = (unsigned*)(ws + WS_CTL);
    for (int u = tid0; u < (LDS_BYTES - LDSCTL_OFF) / 4; u += 512) ((LAS unsigned*)(lds + LDSCTL_OFF))[u] = 0u;
    __syncthreads();
    if (tid0 == 0) {
#pragma unroll
        for (int i = 0; i < 29; ++i) ((LAS unsigned long long*)(lds + PTAB_OFF))[i] = (unsigned long long)args.in.p[i];
    }
    __syncthreads();
    XcdBarrier bar; bar.bar = ctl + CW_BAR; bar.x = 0; bar.st = nullptr;
    if (MK_N_LAUNCHES == 1) bar = xcd_barrier_post(ctl + CW_BAR, MISC + 8, tid0);
    const int lo = args.ph_lo, hi_ = args.ph_hi;
    int phase = 0;
#define PH_BEGIN if (phase >= lo && phase < hi_) { const int tid = fresh_tid(wave0), lane = tid & 63, wave = __builtin_amdgcn_readfirstlane(tid >> 6); (void)lane; (void)wave;
#define PH_END   if (MK_N_LAUNCHES == 1) xcd_barrier(bar, fresh_tid(wave0)); } ++phase;

    bf16_t* H = (bf16_t*)(ws + WS_H); bf16_t* BIG = (bf16_t*)(ws + WS_BIG); bf16_t* ATT = (bf16_t*)(ws + WS_ATT);
    float* mods = (float*)(ws + WS_MODS);

    PH_BEGIN { if (EN(0)) { prologue_phase(ws, lds, G, wg, tid, wave, lane); } } PH_END
    PH_BEGIN { if (EN(1)) { mods_finalize(lds, ws, G, wg, tid); } } PH_END

    layer_phases<0>(lds, ws, out, ctl, bar, G, wg, wave0, lo, hi_, phase);
    layer_phases<1>(lds, ws, out, ctl, bar, G, wg, wave0, lo, hi_, phase);
    PH_BEGIN { if (EN(4)) { final_norm_phase((bf16_t*)(ws + WS_XB), out, inp(lds, 28), SampleFix{(const float*)(ws + WS_PART), 15, (const float*)(ws + WS_MODS) + (size_t)16 * NADA + 8 * DM, 0.5f}, G, wg, wave, lane); } } }
#undef PH_BEGIN
#undef PH_END
}
constexpr int N_PHASES = 64;

extern "C" void kernel_launch(void* const* d_in, const int* in_sizes, int n_in, void* d_out, int out_size, void* d_ws, size_t ws_size, hipStream_t stream) {
    static int grid = 0;
    if (grid == 0) {
        if (n_in != 29 || (size_t)out_size != OUT_TOTAL || ws_size < WS_END) { fprintf(stderr, "kernel_launch: unexpected shapes (n_in %d, out %d, ws %zu; need ws >= %zu)\n", n_in, out_size, ws_size, (size_t)WS_END); grid = -1; return; }
        int dev = 0, cus = 0;
        if (hipGetDevice(&dev) != hipSuccess || hipDeviceGetAttribute(&cus, hipDeviceAttributeMultiprocessorCount, dev) != hipSuccess) { grid = -1; return; }
        if (hipFuncSetAttribute((const void*)mega_fwd, hipFuncAttributeMaxDynamicSharedMemorySize, LDS_BYTES) != hipSuccess) { fprintf(stderr, "kernel_launch: hipFuncSetAttribute failed\n"); grid = -1; return; }
        int per_cu = 0;
        if (hipOccupancyMaxActiveBlocksPerMultiprocessor(&per_cu, (const void*)mega_fwd, 512, LDS_BYTES) != hipSuccess || per_cu < 1) { fprintf(stderr, "kernel_launch: occupancy query says %d blocks per CU\n", per_cu); }
        (void)hipGetLastError();
        grid = cus;
    }
    if (grid < 0) return;
    (void)hipMemsetAsync((char*)d_ws + WS_CTL, 0, 128 * 1024, stream);
    KArgs a{};
    for (int i = 0; i < 29; ++i) a.in.p[i] = (const float*)d_in[i];
    a.out = (float*)d_out; a.ws = (unsigned char*)d_ws;
    if (MK_N_LAUNCHES == 1) { a.ph_lo = 0; a.ph_hi = N_PHASES; hipLaunchKernelGGL(mega_fwd, dim3(grid), dim3(512), LDS_BYTES, stream, a); }
    else { for (int p = 0; p < N_PHASES; ++p) { a.ph_lo = p; a.ph_hi = p + 1; hipLaunchKernelGGL(mega_fwd, dim3(grid), dim3(512), LDS_BYTES, stream, a); } }
}
```
